# Optimizing an MI355X kernel written in HIP

```python
import math
import jax, jax.numpy as jnp
from jax import lax
import numpy as np

D_MODEL = 1024
BATCH = 4
SEQ = 4096
DEPTH = 4
DEC_BATCH = 2
DEC_SEQ = 16384
PAST_LEN = 128

GRID_W = 64
N_MIXERS = 3
D_FF = 4 * D_MODEL
EPS = 1e-6
ROPE_THETA = 10000.0
Q_BLOCK = 128
A_HEAD_DIM = 64
A_HEADS = D_MODEL // A_HEAD_DIM
A_WIN_ROWS = 8
A_WIN_COLS = 16
B_HEAD_DIM = 64
B_HEADS = D_MODEL // B_HEAD_DIM
B_PAIRS = ((128, 1), (512, 4), (2048, 16))
B_GROUPS = len(B_PAIRS)
C_HEAD_DIM = 128
C_Q_HEADS = D_MODEL // C_HEAD_DIM
C_KV_HEADS = 2
C_GROUP = C_Q_HEADS // C_KV_HEADS
C_QKV_WIDTH = (C_Q_HEADS + 2 * C_KV_HEADS) * C_HEAD_DIM
N_A = (DEPTH + 2) // 3
N_B = (DEPTH + 1) // 3
N_C = DEPTH // 3

kernel_name = "hybrid_bidir_encoder_natten_dilated_axial_gqa"


def rms_norm(x, g):
    x32 = x.astype(jnp.float32)
    y = x32 * lax.rsqrt(jnp.mean(x32 * x32, axis=-1, keepdims=True) + EPS)
    return (y * g.astype(jnp.float32)).astype(x.dtype)


def rope(x, pos):
    dim = x.shape[-1]
    half = dim // 2
    inv = ROPE_THETA ** (-jnp.arange(half, dtype=jnp.float32) / half)
    ang = pos.astype(jnp.float32)[:, None] * inv[None, :]
    cos = jnp.cos(ang).astype(x.dtype)
    sin = jnp.sin(ang).astype(x.dtype)
    x1, x2 = x[..., :half], x[..., half:]
    return jnp.concatenate([x1 * cos - x2 * sin, x1 * sin + x2 * cos], axis=-1)


def neighbourhood_attention(h, w_qkv, rpb, w_o):
    bn, seq_len, _ = h.shape
    rows = seq_len // GRID_W
    kr = min(A_WIN_ROWS, rows)
    kc = A_WIN_COLS
    qkv = (h @ w_qkv).reshape(bn, seq_len, 3, A_HEADS, A_HEAD_DIM)
    q = jnp.moveaxis(qkv[:, :, 0], 1, 2)
    k = jnp.moveaxis(qkv[:, :, 1], 1, 2)
    v = jnp.moveaxis(qkv[:, :, 2], 1, 2)
    cols = np.arange(GRID_W)
    col_start = np.clip(cols - kc // 2, 0, GRID_W - kc)
    col_idx = col_start[:, None] + np.arange(kc)[None, :]
    dc_idx = col_idx - cols[:, None] + (A_WIN_COLS - 1)
    scale = A_HEAD_DIM ** -0.5

    def row_fn(r):
        rs = jnp.clip(r - kr // 2, 0, rows - kr)
        key_rows = rs + jnp.arange(kr)
        kidx = (key_rows[None, :, None] * GRID_W + col_idx[:, None, :]).reshape(GRID_W, kr * kc)
        qr = lax.dynamic_slice_in_dim(q, r * GRID_W, GRID_W, axis=2)
        kg = k[:, :, kidx]
        vg = v[:, :, kidx]
        dr_idx = key_rows - r + (A_WIN_ROWS - 1)
        bias = rpb[:, dr_idx[None, :, None], dc_idx[:, None, :]].reshape(A_HEADS, GRID_W, kr * kc)
        s = jnp.einsum("bhqd,bhqkd->bhqk", qr, kg).astype(jnp.float32) * scale + bias.astype(jnp.float32)
        p = jax.nn.softmax(s, axis=-1).astype(v.dtype)
        return jnp.einsum("bhqk,bhqkd->bhqd", p, vg)

    o = lax.map(row_fn, jnp.arange(rows))
    o = jnp.transpose(o, (1, 0, 3, 2, 4)).reshape(bn, seq_len, A_HEADS * A_HEAD_DIM)
    return o @ w_o


def dilated_attention(h, w_qkv, w_o, pos):
    bn, seq_len, _ = h.shape
    nb = seq_len // Q_BLOCK
    qkv = (h @ w_qkv).reshape(bn, seq_len, B_GROUPS, 3, B_HEADS, B_HEAD_DIM)
    scale = B_HEAD_DIM ** -0.5
    outs, lses = [], []
    for g, (win, dil) in enumerate(B_PAIRS):
        q = rope(jnp.moveaxis(qkv[:, :, g, 0], 1, 2), pos)
        k = rope(jnp.moveaxis(qkv[:, :, g, 1], 1, 2), pos)
        v = jnp.moveaxis(qkv[:, :, g, 2], 1, 2)
        n_side = win // (2 * dil)
        offs = dil * np.arange(-n_side, n_side + 1)

        def blk(i, q=q, k=k, v=v, offs=offs):
            t0 = i * Q_BLOCK
            idx = t0 + jnp.arange(Q_BLOCK)[:, None] + offs[None, :]
            valid = (idx >= 0) & (idx < seq_len)
            idxc = jnp.clip(idx, 0, seq_len - 1)
            qb = lax.dynamic_slice_in_dim(q, t0, Q_BLOCK, axis=2)
            kb = k[:, :, idxc]
            vb = v[:, :, idxc]
            s = jnp.einsum("bhqd,bhqkd->bhqk", qb, kb).astype(jnp.float32) * scale
            s = jnp.where(valid[None, None], s, -jnp.inf)
            lse = jax.nn.logsumexp(s, axis=-1)
            p = jnp.exp(s - lse[..., None]).astype(v.dtype)
            return jnp.einsum("bhqk,bhqkd->bhqd", p, vb), lse

        o, lse = lax.map(blk, jnp.arange(nb))
        outs.append(jnp.transpose(o, (1, 2, 0, 3, 4)).reshape(bn, B_HEADS, seq_len, B_HEAD_DIM))
        lses.append(jnp.transpose(lse, (1, 2, 0, 3)).reshape(bn, B_HEADS, seq_len))
    wgt = jax.nn.softmax(jnp.stack(lses), axis=0).astype(h.dtype)
    o = jnp.einsum("gbhl,gbhld->bhld", wgt, jnp.stack(outs))
    o = jnp.moveaxis(o, 1, 2).reshape(bn, seq_len, B_HEADS * B_HEAD_DIM)
    return o @ w_o


def axial_rope(x, row, col):
    half = x.shape[-1] // 2
    return jnp.concatenate([rope(x[..., :half], row), rope(x[..., half:], col)], axis=-1)


def axial_gqa_attention(h, w_qkv, q_g, k_g, w_o, row, col):
    bn, seq_len, _ = h.shape
    nb = seq_len // Q_BLOCK
    qw = C_Q_HEADS * C_HEAD_DIM
    kw = C_KV_HEADS * C_HEAD_DIM
    proj = h @ w_qkv
    q = proj[..., :qw].reshape(bn, seq_len, C_Q_HEADS, C_HEAD_DIM)
    k = proj[..., qw:qw + kw].reshape(bn, seq_len, C_KV_HEADS, C_HEAD_DIM)
    v = proj[..., qw + kw:].reshape(bn, seq_len, C_KV_HEADS, C_HEAD_DIM)
    q = axial_rope(jnp.moveaxis(rms_norm(q, q_g), 1, 2), row, col)
    k = axial_rope(jnp.moveaxis(rms_norm(k, k_g), 1, 2), row, col)
    v = jnp.moveaxis(v, 1, 2)
    q = q.reshape(bn, C_KV_HEADS, C_GROUP, seq_len, C_HEAD_DIM)
    scale = C_HEAD_DIM ** -0.5

    def blk(i):
        qb = lax.dynamic_slice_in_dim(q, i * Q_BLOCK, Q_BLOCK, axis=3)
        s = jnp.einsum("bkgqd,bksd->bkgqs", qb, k).astype(jnp.float32) * scale
        p = jax.nn.softmax(s, axis=-1).astype(v.dtype)
        return jnp.einsum("bkgqs,bksd->bkgqd", p, v)

    o = lax.map(blk, jnp.arange(nb))
    o = jnp.transpose(o, (1, 0, 4, 2, 3, 5)).reshape(bn, seq_len, qw)
    return o @ w_o


def sq_relu_mlp(h, w1, w2):
    return jnp.square(jax.nn.relu(h @ w1)) @ w2


def trunk(x, c, w_mod, b_mod, norm_g, final_g, a_w_qkv, a_rpb, a_w_o, b_w_qkv, b_w_o,
          c_w_qkv, c_q_g, c_k_g, c_w_o, mlp_w1, mlp_w2):
    seq_len = x.shape[1]
    t = jnp.arange(seq_len)
    row = t // GRID_W
    col = t % GRID_W
    c_act = jax.nn.silu(c)
    for i in range(DEPTH):
        mod = (c_act @ w_mod[i] + b_mod[i])[:, None, :]
        sh1, sc1, g1, sh2, sc2, g2 = jnp.split(mod, 6, axis=-1)
        h = rms_norm(x, norm_g[i, 0]) * (1 + sc1) + sh1
        kind, j = i % N_MIXERS, i // N_MIXERS
        if kind == 0:
            m = neighbourhood_attention(h, a_w_qkv[j], a_rpb[j], a_w_o[j])
        elif kind == 1:
            m = dilated_attention(h, b_w_qkv[j], b_w_o[j], t)
        else:
            m = axial_gqa_attention(h, c_w_qkv[j], c_q_g[j], c_k_g[j], c_w_o[j], row, col)
        x = x + g1 * m
        h = rms_norm(x, norm_g[i, 1]) * (1 + sc2) + sh2
        x = x + g2 * sq_relu_mlp(h, mlp_w1[i], mlp_w2[i])
    return rms_norm(x, final_g)


def setup_inputs(seed: int = 0) -> dict:
    key = jax.random.key(seed)
    ks = jax.random.split(key, 20)
    D = D_MODEL

    def nrm(k, shape, scale):
        return jax.random.normal(k, shape, jnp.float32) * scale

    return {
        "x_prompt": nrm(ks[0], (BATCH, SEQ, D), 1.0),
        "x_sample": nrm(ks[1], (DEC_BATCH, DEC_SEQ, D), 1.0),
        "c_prompt": nrm(ks[2], (BATCH, D), 1.0),
        "c_sample": nrm(ks[3], (DEC_BATCH, D), 1.0),
        "w_mod": nrm(ks[4], (DEPTH, D, 6 * D), 0.5 * D ** -0.5),
        "b_mod": nrm(ks[5], (DEPTH, 6 * D), 0.02),
        "norm_g": 1.0 + nrm(ks[6], (DEPTH, 2, D), 0.02),
        "final_g": 1.0 + nrm(ks[7], (D,), 0.02),
        "a_w_qkv": nrm(ks[8], (N_A, D, 3 * A_HEADS * A_HEAD_DIM), D ** -0.5),
        "a_rpb": nrm(ks[9], (N_A, A_HEADS, 2 * A_WIN_ROWS - 1, 2 * A_WIN_COLS - 1), 0.1),
        "a_w_o": nrm(ks[10], (N_A, A_HEADS * A_HEAD_DIM, D), (A_HEADS * A_HEAD_DIM) ** -0.5),
        "b_w_qkv": nrm(ks[11], (N_B, D, B_GROUPS * 3 * B_HEADS * B_HEAD_DIM), D ** -0.5),
        "b_w_o": nrm(ks[12], (N_B, B_HEADS * B_HEAD_DIM, D), (B_HEADS * B_HEAD_DIM) ** -0.5),
        "c_w_qkv": nrm(ks[13], (N_C, D, C_QKV_WIDTH), D ** -0.5),
        "c_q_g": 1.0 + nrm(ks[14], (N_C, C_HEAD_DIM), 0.02),
        "c_k_g": 1.0 + nrm(ks[15], (N_C, C_HEAD_DIM), 0.02),
        "c_w_o": nrm(ks[16], (N_C, C_Q_HEADS * C_HEAD_DIM, D), (C_Q_HEADS * C_HEAD_DIM) ** -0.5),
        "mlp_w1": nrm(ks[17], (DEPTH, D, D_FF), D ** -0.5),
        "mlp_w2": nrm(ks[18], (DEPTH, D_FF, D), D_FF ** -0.5),
    }


def reference(x_prompt, x_sample, c_prompt, c_sample, w_mod, b_mod, norm_g, final_g,
              a_w_qkv, a_rpb, a_w_o, b_w_qkv, b_w_o, c_w_qkv, c_q_g, c_k_g, c_w_o,
              mlp_w1, mlp_w2):
    y_prompt = trunk(x_prompt, c_prompt, w_mod, b_mod, norm_g, final_g, a_w_qkv, a_rpb, a_w_o,
                     b_w_qkv, b_w_o, c_w_qkv, c_q_g, c_k_g, c_w_o, mlp_w1, mlp_w2)
    y_sample = trunk(x_sample, c_sample, w_mod, b_mod, norm_g, final_g, a_w_qkv, a_rpb, a_w_o,
                     b_w_qkv, b_w_o, c_w_qkv, c_q_g, c_k_g, c_w_o, mlp_w1, mlp_w2)
    return (y_prompt, y_sample)
```

```cpp
#include <hip/hip_runtime.h>
#include <hip/hip_cooperative_groups.h>
#include <cstdio>
#include <cstdint>
#include <cmath>
namespace cg = cooperative_groups;

#ifndef MK_MULTI
#define MK_MULTI 0
#endif

#define LAS __attribute__((address_space(3)))
typedef unsigned short bf16_t;
typedef short bf16x8 __attribute__((ext_vector_type(8)));
typedef short s16x4 __attribute__((ext_vector_type(4)));
typedef float f32x4 __attribute__((ext_vector_type(4)));
typedef float f32x8 __attribute__((ext_vector_type(8)));
typedef float f32x16 __attribute__((ext_vector_type(16)));
typedef unsigned u32x4 __attribute__((ext_vector_type(4)));
typedef unsigned u32x2 __attribute__((ext_vector_type(2)));

constexpr int T = 49152;
constexpr int TP = 16384;
constexpr int DM = 1024, FF = 4096;
constexpr float EPS = 1e-6f;
constexpr float LOG2E = 1.4426950408889634f;
constexpr int NTHREADS = 512;

constexpr size_t MiB = 1048576;
constexpr size_t WS_W = 0;
constexpr size_t WS_MOD = 105 * MiB;
constexpr size_t WS_BAR = 105 * MiB + 768 * 1024;
constexpr size_t WS_ROPE = 106 * MiB;
constexpr size_t WS_LSE = 110 * MiB;
constexpr size_t WS_H = 113 * MiB;
constexpr size_t WS_R = 209 * MiB;
constexpr size_t R_VT = 205 * MiB;
constexpr int LDA_QK = 2048 + 128;
constexpr int LDA_VT = T + 128;
constexpr int LDB_QK = 6144 + 128;
constexpr int LDB_VT = 16384 + 128;
constexpr int LDU = 4096 + 128;
constexpr size_t WS_END = 512 * MiB;
constexpr size_t W_AQKV = 0;
constexpr size_t W_AO = 6291456;
constexpr size_t W_BQKV = 8388608;
constexpr size_t W_BO = 17825792;
constexpr size_t W_CQKV = 18874368;
constexpr size_t W_CO = 20447232;
constexpr size_t W_1 = 21495808;
constexpr size_t W_2 = 38273024;
constexpr int LDS_BYTES = 159744;

struct Ph { short type, a, b, c; };
enum { PH_INIT = 0, PH_MOD, PH_QKV_A, PH_NATTEN, PH_WO, PH_MLP, PH_QKV_B, PH_DIL, PH_MERGE, PH_QKV_C, PH_QKNORM, PH_ATTN_C, PH_FINAL };
constexpr int MAXPH = 96;
struct Params {
    const float *x_prompt, *x_sample, *c_prompt, *c_sample, *w_mod, *b_mod, *norm_g, *final_g, *a_w_qkv, *a_rpb, *a_w_o, *b_w_qkv, *b_w_o,
        *c_w_qkv, *c_q_g, *c_k_g, *c_w_o, *mlp_w1, *mlp_w2;
    float* out; unsigned char* ws;
    int nph, pad;
};
struct PhTab { Ph v[MAXPH]; int n; };
#ifndef PROBE_DRYBIT
#define PROBE_DRYBIT 0x100
#endif
#ifndef PROBE_MASK
#define PROBE_MASK 0
#endif
constexpr void tab_add1(PhTab& t, int type, int a, int b, int c) { t.v[t.n].type = (short)type; t.v[t.n].a = (short)a; t.v[t.n].b = (short)b; t.v[t.n].c = (short)c; t.n++; }
constexpr void tab_add(PhTab& t, int type, int a, int b, int c) { if ((PROBE_MASK >> type) & 1) tab_add1(t, type | PROBE_DRYBIT, a, b, c); tab_add1(t, type, a, b, c); }
constexpr PhTab make_tab() {
    PhTab t{};
    tab_add(t, PH_INIT, 0, 0, 0);
    for (int layer = 0; layer < 4; ++layer) {
        const int kind = layer % 3, j = layer / 3;
        if (kind == 0) {
            tab_add(t, PH_MOD, layer, 0, -1); tab_add(t, PH_QKV_A, j, 0, 0); tab_add(t, PH_NATTEN, j, 0, 0); tab_add(t, PH_WO, layer, 0, j);
        } else if (kind == 1) {
            tab_add(t, PH_MOD, layer, 0, -1);
            for (int c = 0; c < 3; ++c) { tab_add(t, PH_QKV_B, 0, 0, c); tab_add(t, PH_DIL, 0, 0, c); tab_add(t, PH_MERGE, 0, 0, c); }
            tab_add(t, PH_WO, layer, 1, 0);
        } else {
            tab_add(t, PH_MOD, layer, 0, -1); tab_add(t, PH_QKV_C, 0, 0, 0); tab_add(t, PH_QKNORM, 0, 0, 0); tab_add(t, PH_ATTN_C, 0, 0, 0); tab_add(t, PH_WO, layer, 2, 0);
        }
        tab_add(t, PH_MOD, layer, 1, -1);
        for (int s = 0; s < 4; ++s) tab_add(t, PH_MLP, layer, s, 0);
    }
    tab_add(t, PH_FINAL, 0, 0, 0);
    return t;
}
constexpr PhTab H_TAB = make_tab();
__constant__ PhTab g_tab = make_tab();
__constant__ float g_inv[32] = {1.000000000e+00f, 7.498942018e-01f, 5.623413324e-01f, 4.216965139e-01f, 3.162277639e-01f, 2.371373773e-01f, 1.778279394e-01f, 1.333521456e-01f, 1.000000015e-01f, 7.498942316e-02f, 5.623413250e-02f, 4.216964915e-02f, 3.162277490e-02f, 2.371373773e-02f, 1.778279431e-02f, 1.333521400e-02f, 9.999999776e-03f, 7.498942316e-03f, 5.623413250e-03f, 4.216964822e-03f, 3.162277630e-03f, 2.371373819e-03f, 1.778279431e-03f, 1.333521446e-03f, 1.000000047e-03f, 7.498941850e-04f, 5.623413017e-04f, 4.216965172e-04f, 3.162277571e-04f, 2.371373703e-04f, 1.778279402e-04f, 1.333521504e-04f};

typedef const __attribute__((address_space(4))) Params* PP;
__device__ __forceinline__ PP params_() { PP kp = (PP)__builtin_amdgcn_kernarg_segment_ptr(); asm volatile("" : "+s"(kp)); return kp; }
__device__ __forceinline__ int tid_() { int t = (int)threadIdx.x; asm volatile("" : "+v"(t)); return t; }
__device__ __forceinline__ int bid_() { int b = (int)blockIdx.x; asm volatile("" : "+s"(b)); return b; }
__device__ __forceinline__ unsigned cvt_pk_bf16(float lo, float hi) { unsigned r; asm volatile("v_cvt_pk_bf16_f32 %0, %1, %2" : "=v"(r) : "v"(lo), "v"(hi)); return r; }
__device__ __forceinline__ float bf_lo(unsigned w) { return __uint_as_float(w << 16); }
__device__ __forceinline__ float bf_hi(unsigned w) { return __uint_as_float(w & 0xffff0000u); }
__device__ __forceinline__ float wave_sum(float v) {
    v += __shfl_xor(v, 32); v += __shfl_xor(v, 16); v += __shfl_xor(v, 8); v += __shfl_xor(v, 4); v += __shfl_xor(v, 2); v += __shfl_xor(v, 1); return v;
}
__device__ __forceinline__ int seq_of_row(int m) { return m < TP ? (m >> 12) : 4 + ((m - TP) >> 14); }
__device__ __forceinline__ const float* mod_vec(PP p, int s, int layer, int which) {
    return (const float*)(p->ws + WS_MOD) + ((size_t)(s * 4 + layer) * 6 + which) * DM;
}

namespace pg8 {
constexpr int BM = 256, BK = 64, HALF = 128, HTB = HALF * BK * 2, STAGE_BYTES = 8 * HTB, NXCD = 8, WGM = 8;
__host__ __device__ __forceinline__ int lds_byte(int r, int c) { const int st = (r >> 4) * 2 + (c >> 5), rr = r & 15, cc = c & 31, ob = rr * 64 + cc * 2; return st * 1024 + (ob ^ (((ob >> 9) & 1) << 5)); }
__host__ __device__ __forceinline__ void stage_rc(int b, int& R, int& C) { const int st = b / 1024, sb = b % 1024, swz = sb ^ (((sb >> 9) & 1) << 5); R = (st >> 1) * 16 + swz / 64; C = (st & 1) * 32 + (swz % 64) / 2; }
__host__ __device__ __forceinline__ int perm32(int rho) { const int n = rho >> 4, i = rho & 15; return 8 * (i >> 2) + 4 * n + (i & 3); }

struct Unit { int pm, pn; };
struct Gemm { const bf16_t* A; const bf16_t* Bt; int lda, ldb, M, N, K;
              int pA_L, pA_d, pA_S, pB_L, pB_d, pB_S; };
__device__ __forceinline__ const char* tile_base(const bf16_t* base, int t, size_t tstep, int pL, int pd, int pS) {
    if (pL < 0) return (const char*)base + (size_t)t * tstep;
    const int p0 = t << 8, line = p0 >> pL, u0 = p0 & ((1 << pL) - 1), sb = line >> pd, rho = line & ((1 << pd) - 1);
    return (const char*)base + (size_t)((sb << pS) + rho + (u0 << pd)) * 2048;
}
struct StaticOrder {
    int nM, nN, nwg, G, c;
    __device__ void init(int M, int N, int G_, int c_) { nM = M / BM; nN = N / BM; nwg = nM * nN; G = G_; c = c_; }
    __device__ bool next(int i, Unit& u) const {
        const long L = (long)i * G + c; if (L >= nwg) return false;
        int wgid = (int)L; { const int q = nwg / NXCD, r = nwg % NXCD, xcd = wgid % NXCD, off = wgid / NXCD; wgid = (xcd < r ? xcd * (q + 1) : r * (q + 1) + (xcd - r) * q) + off; }
        const int nig = WGM * nN, gid = wgid / nig, fm = gid * WGM, gsz = (nM - fm) < WGM ? (nM - fm) : WGM;
        u.pm = fm + ((wgid % nig) % gsz); u.pn = (wgid % nig) / gsz; return true;
    }
};

struct Epi {
    int dry;
    int mode;
    bf16_t* O; int ldc;
    int log2L, log2d;
    const float* rope;
    const float* base_p; const float* base_s; const bf16_t* baseb; bf16_t* outb; const float* gate; int row_off;
    __device__ __forceinline__ void operator()(const f32x4 (&acc)[2][2][4][2], const Unit& u, int wr, int wc, int fr, int fq) const {
        const int row0 = u.pm * BM + wr * 64 + fr, col0 = u.pn * BM + wc * 32 + 8 * fq;
        if (dry) return;
        if (mode == 3) {
            const int g0 = row_off + u.pm * BM; const int s = seq_of_row(g0);
            const float* gv = gate + (size_t)s * (4 * 6 * DM) + col0;
            f32x4 gt[2][2];
#pragma unroll
            for (int bj = 0; bj < 2; ++bj)
#pragma unroll
                for (int n = 0; n < 2; ++n) gt[bj][n] = *(const f32x4*)(gv + bj * HALF + 4 * n);
            if (base_p) {
#pragma unroll
                for (int ai = 0; ai < 2; ++ai)
#pragma unroll
                    for (int m = 0; m < 4; ++m) {
                        const int gr = row_off + row0 + ai * HALF + m * 16;
                        bf16_t* op = outb + (size_t)gr * DM;
#pragma unroll
                        for (int bj = 0; bj < 2; ++bj) {
                            const int c = col0 + bj * HALF;
                            const float* bp = (gr < TP ? base_p + (size_t)gr * DM : base_s + (size_t)(gr - TP) * DM) + c;
                            const f32x4 b0 = *(const f32x4*)bp, b1 = *(const f32x4*)(bp + 4);
                            const f32x4 v0 = b0 + gt[bj][0] * acc[ai][bj][m][0], v1 = b1 + gt[bj][1] * acc[ai][bj][m][1];
                            u32x4 w; w.x = cvt_pk_bf16(v0[0], v0[1]); w.y = cvt_pk_bf16(v0[2], v0[3]); w.z = cvt_pk_bf16(v1[0], v1[1]); w.w = cvt_pk_bf16(v1[2], v1[3]);
                            *(u32x4*)(op + c) = w;
                        }
                    }
            } else {
#pragma unroll
                for (int ai = 0; ai < 2; ++ai) {
                    u32x4 bb[4][2];
#pragma unroll
                    for (int m = 0; m < 4; ++m) { const bf16_t* bp = baseb + (size_t)(row_off + row0 + ai * HALF + m * 16) * DM + col0;
#pragma unroll
                        for (int bj = 0; bj < 2; ++bj) bb[m][bj] = *(const u32x4*)(bp + bj * HALF); }
                    __builtin_amdgcn_sched_barrier(0);
#pragma unroll
                    for (int m = 0; m < 4; ++m) { bf16_t* op = outb + (size_t)(row_off + row0 + ai * HALF + m * 16) * DM + col0;
#pragma unroll
                        for (int bj = 0; bj < 2; ++bj) { const u32x4 ub = bb[m][bj];
                            const f32x4 b0 = {bf_lo(ub.x), bf_hi(ub.x), bf_lo(ub.y), bf_hi(ub.y)}, b1 = {bf_lo(ub.z), bf_hi(ub.z), bf_lo(ub.w), bf_hi(ub.w)};
                            const f32x4 v0 = b0 + gt[bj][0] * acc[ai][bj][m][0], v1 = b1 + gt[bj][1] * acc[ai][bj][m][1];
                            u32x4 w; w.x = cvt_pk_bf16(v0[0], v0[1]); w.y = cvt_pk_bf16(v0[2], v0[3]); w.z = cvt_pk_bf16(v1[0], v1[1]); w.w = cvt_pk_bf16(v1[2], v1[3]);
                            *(u32x4*)(op + bj * HALF) = w; } }
                    __builtin_amdgcn_sched_barrier(0);
                }
            }
            return;
        }
#pragma unroll
        for (int ai = 0; ai < 2; ++ai)
#pragma unroll
            for (int m = 0; m < 4; ++m) {
                const int row = row0 + ai * HALF + m * 16;
                bf16_t* rowp = O + (size_t)row * ldc + col0;
                f32x4 cs0 = {1.f, 0.f, 1.f, 0.f}, cs1 = {1.f, 0.f, 1.f, 0.f};
                if (mode == 1) {
                    const int L1 = (1 << log2L) - 1, line = row >> log2L, uu = row & L1, rho = line & ((1 << log2d) - 1), pos = (uu << log2d) + rho;
                    const float* tp = rope + ((size_t)pos * 32 + (wc & 1) * 16 + 4 * fq) * 2;
                    cs0 = *(const f32x4*)tp; cs1 = *(const f32x4*)(tp + 4);
                }
#pragma unroll
                for (int bj = 0; bj < 2; ++bj) {
                    f32x4 v0 = acc[ai][bj][m][0], v1 = acc[ai][bj][m][1];
                    if (mode == 2) {
#pragma unroll
                        for (int e = 0; e < 4; ++e) { float a = fmaxf(v0[e], 0.f), b = fmaxf(v1[e], 0.f); v0[e] = a * a; v1[e] = b * b; }
                    } else if (mode == 1) {
                        f32x4 r0, r1;
                        r0[0] = v0[0] * cs0[0] - v0[1] * cs0[1]; r0[1] = v0[0] * cs0[1] + v0[1] * cs0[0];
                        r0[2] = v0[2] * cs0[2] - v0[3] * cs0[3]; r0[3] = v0[2] * cs0[3] + v0[3] * cs0[2];
                        r1[0] = v1[0] * cs1[0] - v1[1] * cs1[1]; r1[1] = v1[0] * cs1[1] + v1[1] * cs1[0];
                        r1[2] = v1[2] * cs1[2] - v1[3] * cs1[3]; r1[3] = v1[2] * cs1[3] + v1[3] * cs1[2];
                        v0 = r0; v1 = r1;
                    }
                    u32x4 w; w.x = cvt_pk_bf16(v0[0], v0[1]); w.y = cvt_pk_bf16(v0[2], v0[3]); w.z = cvt_pk_bf16(v1[0], v1[1]); w.w = cvt_pk_bf16(v1[2], v1[3]);
                    *(u32x4*)(rowp + bj * HALF) = w;
                }
            }
    }
};

__device__ __forceinline__ void gemm_phase(LAS unsigned char* lds, const Gemm g, const StaticOrder& S, const Epi& E) {
    const int tid = tid_(), wid = __builtin_amdgcn_readfirstlane(tid >> 6), lane = tid & 63, wr = wid >> 2, wc = wid & 3, fr = lane & 15, fq = lane >> 4;
    const int K = g.K, nt = K / BK;
    unsigned voffA[2], voffB[2];
#pragma unroll
    for (int i = 0; i < 2; ++i) { int R, C; stage_rc(tid * 16 + i * 8192, R, C); const int Rb = (R & ~31) + perm32(R & 31);
        voffA[i] = (unsigned)(R * g.lda + C) * 2u; voffB[i] = (unsigned)(Rb * g.ldb + C) * 2u; }
    const size_t kstep = (size_t)(BK * 2);
    const size_t hstepA = (size_t)HALF * g.lda * 2, hstepB = (size_t)HALF * g.ldb * 2;
    const size_t tstepA = 2 * hstepA, tstepB = 2 * hstepB;
    const unsigned ldsw = (unsigned)wid * 1024u;
    const int aoff = lds_byte(wr * 64 + fr, fq * 8), boff = lds_byte(wc * 32 + fr, fq * 8);
#define PG8_SA(b, h) (((b) * 2 + (h)) * HTB)
#define PG8_SB(b, h) ((4 + (b) * 2 + (h)) * HTB)
#define PG8_STAGE(bufoff, gbase, voff) do { _Pragma("unroll") for (int _i = 0; _i < 2; ++_i) \
        __builtin_amdgcn_global_load_lds((const unsigned*)((const char*)(gbase) + (voff)[_i]), (LAS unsigned*)(lds + (bufoff) + ldsw + _i * 8192), 16, 0, 0); } while (0)
#define PG8_LDA(dst, b, h) do { _Pragma("unroll") for (int m = 0; m < 4; ++m) _Pragma("unroll") for (int k = 0; k < 2; ++k) dst[m][k] = *(const LAS bf16x8*)(lds + PG8_SA(b, h) + aoff + m * 2048 + k * 1024); } while (0)
#define PG8_LDB(dst, b, h) do { _Pragma("unroll") for (int n = 0; n < 2; ++n) _Pragma("unroll") for (int k = 0; k < 2; ++k) dst[n][k] = *(const LAS bf16x8*)(lds + PG8_SB(b, h) + boff + n * 2048 + k * 1024); } while (0)
#define PG8_MMA(ai, bj, At, Bt) do { __builtin_amdgcn_s_setprio(1); _Pragma("unroll") for (int m = 0; m < 4; ++m) _Pragma("unroll") for (int n = 0; n < 2; ++n) _Pragma("unroll") for (int k = 0; k < 2; ++k) \
        acc[ai][bj][m][n] = __builtin_amdgcn_mfma_f32_16x16x32_bf16(Bt[n][k], At[m][k], acc[ai][bj][m][n], 0, 0, 0); __builtin_amdgcn_s_setprio(0); } while (0)
#define PG8_WAIT_V(n) asm volatile("s_waitcnt vmcnt(" #n ")" ::: "memory")
#define PG8_WAIT_L(n) asm volatile("s_waitcnt lgkmcnt(" #n ")" ::: "memory")
#define PG8_BAR __builtin_amdgcn_s_barrier()
#define PG8_SCHED __builtin_amdgcn_sched_barrier(0)
    Unit cur, nxt; int ui = 0;
    if (!S.next(0, cur)) return;
    f32x4 acc[2][2][4][2];
#pragma unroll
    for (int a = 0; a < 2; ++a)
#pragma unroll
        for (int b = 0; b < 2; ++b)
#pragma unroll
            for (int m = 0; m < 4; ++m)
#pragma unroll
                for (int n = 0; n < 2; ++n) acc[a][b][m][n] = (f32x4){0.f, 0.f, 0.f, 0.f};
    bf16x8 At[4][2], B0[2][2], B1[2][2];
    const char* cA = tile_base(g.A, cur.pm, tstepA, g.pA_L, g.pA_d, g.pA_S); const char* cB = tile_base(g.Bt, cur.pn, tstepB, g.pB_L, g.pB_d, g.pB_S);
    PG8_STAGE(PG8_SB(0, 0), cB, voffB); PG8_STAGE(PG8_SB(0, 1), cB + hstepB, voffB); PG8_STAGE(PG8_SA(0, 0), cA, voffA); PG8_STAGE(PG8_SA(0, 1), cA + hstepA, voffA);
    if (wr == 1) PG8_BAR;
    PG8_WAIT_V(2); PG8_BAR;
    PG8_STAGE(PG8_SB(1, 0), cB + kstep, voffB); PG8_STAGE(PG8_SA(1, 0), cA + kstep, voffA); PG8_STAGE(PG8_SB(1, 1), cB + hstepB + kstep, voffB);
    PG8_WAIT_V(6); PG8_BAR;
    for (;;) {
        const bool has_next = S.next(ui + 1, nxt);
        const char* nA = has_next ? tile_base(g.A, nxt.pm, tstepA, g.pA_L, g.pA_d, g.pA_S) : cA; const char* nB = has_next ? tile_base(g.Bt, nxt.pn, tstepB, g.pB_L, g.pB_d, g.pB_S) : cB;
        for (int t = 0; t < nt; t += 2) {
            const bool last = (t == nt - 2);
            const char* a1 = cA + (size_t)(t + 1) * kstep;
            const char* a2 = last ? nA : cA + (size_t)(t + 2) * kstep; const char* b2 = last ? nB : cB + (size_t)(t + 2) * kstep;
            const char* a3 = a2 + kstep; const char* b3 = b2 + kstep;
            PG8_LDB(B0, 0, 0); PG8_LDB(B1, 0, 1); PG8_SCHED; PG8_LDA(At, 0, 0); PG8_STAGE(PG8_SA(1, 1), a1 + hstepA, voffA);
            PG8_WAIT_V(8); PG8_WAIT_L(0); PG8_BAR; PG8_MMA(0, 0, At, B0); PG8_MMA(0, 1, At, B1); PG8_BAR; PG8_SCHED;
            PG8_LDA(At, 0, 1); PG8_STAGE(PG8_SB(0, 0), b2, voffB); PG8_STAGE(PG8_SB(0, 1), b2 + hstepB, voffB); PG8_STAGE(PG8_SA(0, 0), a2, voffA);
            PG8_WAIT_V(8); PG8_WAIT_L(0); PG8_BAR; PG8_MMA(1, 0, At, B0); PG8_MMA(1, 1, At, B1); PG8_BAR; PG8_SCHED;
            PG8_LDB(B0, 1, 0); PG8_LDB(B1, 1, 1); PG8_SCHED; PG8_LDA(At, 1, 0); PG8_STAGE(PG8_SA(0, 1), a2 + hstepA, voffA);
            PG8_WAIT_V(8); PG8_WAIT_L(0); PG8_BAR; PG8_MMA(0, 0, At, B0); PG8_MMA(0, 1, At, B1); PG8_BAR; PG8_SCHED;
            PG8_LDA(At, 1, 1); PG8_STAGE(PG8_SB(1, 0), b3, voffB); PG8_STAGE(PG8_SB(1, 1), b3 + hstepB, voffB); PG8_STAGE(PG8_SA(1, 0), a3, voffA);
            PG8_WAIT_V(8); PG8_WAIT_L(0); PG8_BAR; PG8_MMA(1, 0, At, B0); PG8_MMA(1, 1, At, B1); PG8_BAR; PG8_SCHED;
        }
        if (wr == 0) PG8_BAR;
        E(acc, cur, wr, wc, fr, fq);
        if (!has_next) break;
#pragma unroll
        for (int a = 0; a < 2; ++a)
#pragma unroll
            for (int b = 0; b < 2; ++b)
#pragma unroll
                for (int m = 0; m < 4; ++m)
#pragma unroll
                    for (int n = 0; n < 2; ++n) acc[a][b][m][n] = (f32x4){0.f, 0.f, 0.f, 0.f};
        cur = nxt; cA = nA; cB = nB; ++ui;
        if (wr == 1) PG8_BAR;
    }
    if (E.dry) PG8_WAIT_V(0); else PG8_WAIT_V(16);
    PG8_BAR;
#undef PG8_SA
#undef PG8_SB
#undef PG8_STAGE
#undef PG8_LDA
#undef PG8_LDB
#undef PG8_MMA
#undef PG8_WAIT_V
#undef PG8_WAIT_L
#undef PG8_BAR
#undef PG8_SCHED
}
}

namespace att {
constexpr int D = 128, NW = 8, QBLK = 32, KVBLK = 64;
constexpr float SCALE = 0.088388347648318440f;
constexpr float THR = 8.f;
constexpr int LDQ = 1536, LDK = 1536, LDO = 1024;
constexpr size_t SHM_V = KVBLK * D * 2, SHM_K = KVBLK * D * 2, SHM_ATTN = 3 * SHM_V + 3 * SHM_K + NW * 64 * 4;
#define KSWZ(row, colB) ((row) * 256 + ((colB) ^ (((row) & 7) << 4)))
#define SBAR() __builtin_amdgcn_sched_barrier(0)
__device__ __forceinline__ int crow(int r, int hi) { return (r & 3) + 8 * (r >> 2) + 4 * hi; }
__device__ __forceinline__ void partialSM(f32x16& p0, f32x16& p1, float& m_reg, float& mn, float& alpha) {
    constexpr float C = SCALE * 1.4426950408889634f;
    float pmax = p0[0];
#pragma unroll
    for (int r = 1; r < 16; ++r) pmax = fmaxf(pmax, p0[r]);
#pragma unroll
    for (int r = 0; r < 16; ++r) pmax = fmaxf(pmax, p1[r]);
    { auto rr = __builtin_amdgcn_permlane32_swap(__float_as_uint(pmax), __float_as_uint(pmax), false, false);
      pmax = fmaxf(__uint_as_float(rr[0]), __uint_as_float(rr[1])); }
    if (__builtin_expect(__all(pmax - m_reg <= THR / SCALE), 1)) { mn = m_reg; alpha = 1.f; }
    else { mn = fmaxf(m_reg, pmax); alpha = __builtin_amdgcn_exp2f((m_reg - mn) * C); m_reg = mn; }
    float mnC = -mn * C;
#pragma unroll
    for (int r = 0; r < 16; ++r) p0[r] = fmaf(p0[r], C, mnC);
#pragma unroll
    for (int r = 0; r < 16; ++r) p1[r] = fmaf(p1[r], C, mnC);
#pragma unroll
    for (int r = 0; r < 16; ++r) p0[r] = __builtin_amdgcn_exp2f(p0[r]);
}
__device__ __forceinline__ void finishSM(f32x16& p0, f32x16& p1, float alpha, float& l_reg, bf16x8& pa0, bf16x8& pa1, bf16x8& pa2, bf16x8& pa3) {
#pragma unroll
    for (int r = 0; r < 16; ++r) p1[r] = __builtin_amdgcn_exp2f(p1[r]);
    float ps = 0;
#pragma unroll
    for (int r = 0; r < 16; ++r) ps += p0[r];
#pragma unroll
    for (int r = 0; r < 16; ++r) ps += p1[r];
    { auto rr = __builtin_amdgcn_permlane32_swap(__float_as_uint(ps), __float_as_uint(ps), false, false);
      ps = __uint_as_float(rr[0]) + __uint_as_float(rr[1]); }
    l_reg = l_reg * alpha + ps;
#define PK4(P, BASE, OUT) do { unsigned a0 = cvt_pk_bf16(P[BASE + 0], P[BASE + 1]), a1 = cvt_pk_bf16(P[BASE + 2], P[BASE + 3]);   \
    unsigned b0 = cvt_pk_bf16(P[BASE + 4], P[BASE + 5]), b1 = cvt_pk_bf16(P[BASE + 6], P[BASE + 7]);                              \
    auto r0 = __builtin_amdgcn_permlane32_swap(a0, b0, false, false); auto r1 = __builtin_amdgcn_permlane32_swap(a1, b1, false, false); \
    u32x4 w = {r0[0], r1[0], r0[1], r1[1]}; OUT = *reinterpret_cast<bf16x8*>(&w); } while (0)
    PK4(p0, 0, pa0); PK4(p0, 8, pa1); PK4(p1, 0, pa2); PK4(p1, 8, pa3);
#undef PK4
}
__device__ __forceinline__ void qkt(f32x16& p0, f32x16& p1, const bf16_t* Ks, const bf16x8* qr, int r32, int hi) {
    p0 = f32x16{}; p1 = f32x16{};
#pragma unroll
    for (int d0 = 0; d0 < 8; ++d0) { int cb = (d0 * 16 + hi * 8) * 2;
        bf16x8 b0 = *reinterpret_cast<const bf16x8*>((const char*)Ks + KSWZ(r32, cb));
        bf16x8 b1 = *reinterpret_cast<const bf16x8*>((const char*)Ks + KSWZ(32 + r32, cb));
        p0 = __builtin_amdgcn_mfma_f32_32x32x16_bf16(b0, qr[d0], p0, 0, 0, 0);
        p1 = __builtin_amdgcn_mfma_f32_32x32x16_bf16(b1, qr[d0], p1, 0, 0, 0); }
}
__device__ __forceinline__ int v_st(int k, int c) { const int kk = (k & ~0xC) | ((k & 4) << 1) | ((k & 8) >> 1); return ((kk >> 3) * 4 + (c >> 5)) * 512 + ((kk & 7) * 32 + (c & 31)) * 2; }
__device__ __forceinline__ int v_rd_base(int lane) { return ((lane & 3) << 3) | (((lane >> 2) & 3) << 6) | (((lane >> 4) & 1) << 5) | (((lane >> 5) & 1) << 8); }
constexpr int v_rd_off(int d0, int ks, int half) { return d0 * 512 + ks * 4096 + half * 2048; }
template <int OFF> __device__ __forceinline__ s16x4 tr_read(int vb) {
    s16x4 r; asm volatile("ds_read_b64_tr_b16 %0, %1 offset:%2" : "=&v"(r) : "v"(vb), "i"(OFF) : "memory"); return r;
}
template <int D0> __device__ __forceinline__ void pv_one(f32x16& od, int vb, bf16x8 pa0, bf16x8 pa1, bf16x8 pa2, bf16x8 pa3) {
    const s16x4 l0 = tr_read<v_rd_off(D0, 0, 0)>(vb), h0 = tr_read<v_rd_off(D0, 0, 1)>(vb), l1 = tr_read<v_rd_off(D0, 1, 0)>(vb), h1 = tr_read<v_rd_off(D0, 1, 1)>(vb);
    const s16x4 l2 = tr_read<v_rd_off(D0, 2, 0)>(vb), h2 = tr_read<v_rd_off(D0, 2, 1)>(vb), l3 = tr_read<v_rd_off(D0, 3, 0)>(vb), h3 = tr_read<v_rd_off(D0, 3, 1)>(vb);
    asm volatile("s_waitcnt lgkmcnt(0)" ::: "memory"); SBAR();
#define PK(L, H) (bf16x8){L[0], L[1], L[2], L[3], H[0], H[1], H[2], H[3]}
    od = __builtin_amdgcn_mfma_f32_32x32x16_bf16(pa0, PK(l0, h0), od, 0, 0, 0);
    od = __builtin_amdgcn_mfma_f32_32x32x16_bf16(pa1, PK(l1, h1), od, 0, 0, 0);
    od = __builtin_amdgcn_mfma_f32_32x32x16_bf16(pa2, PK(l2, h2), od, 0, 0, 0);
    od = __builtin_amdgcn_mfma_f32_32x32x16_bf16(pa3, PK(l3, h3), od, 0, 0, 0);
#undef PK
}
__device__ __forceinline__ void pv_d0(f32x16* o, int vb, bf16x8 pa0, bf16x8 pa1, bf16x8 pa2, bf16x8 pa3) {
    pv_one<0>(o[0], vb, pa0, pa1, pa2, pa3); pv_one<1>(o[1], vb, pa0, pa1, pa2, pa3); pv_one<2>(o[2], vb, pa0, pa1, pa2, pa3); pv_one<3>(o[3], vb, pa0, pa1, pa2, pa3);
}
__device__ __forceinline__ void attn_dense_body(const bf16_t* __restrict__ Qb, const bf16_t* __restrict__ Kh, const bf16_t* __restrict__ Vh,
                                                bf16_t* __restrict__ Ob, int seq, char* lds, int dry) {
    const int tid = tid_(), wid = tid >> 6, lane = tid & 63, r32 = lane & 31, hi = lane >> 5;
    bf16_t* V_lds = (bf16_t*)lds; bf16_t* K_lds = (bf16_t*)(lds + 3 * SHM_V);
    float* ws = (float*)(lds + 3 * SHM_V + 3 * SHM_K) + wid * 64; float* li_l = ws; float* al_l = ws + 32;
    float m_reg = -1e30f, l_reg = 0; f32x16 o[4] = {}; bf16x8 qr[8];
    const bf16_t* Qw = Qb + (long)(wid * QBLK + r32) * LDQ + hi * 8;
#pragma unroll
    for (int d0 = 0; d0 < 8; ++d0) qr[d0] = *reinterpret_cast<const bf16x8*>(Qw + d0 * 16);
    const int sr = tid >> 4, sc = (tid & 15) * 8, vst0 = v_st(sr, sc), vst1 = v_st(32 + sr, sc);
    const int vb0 = (int)(uintptr_t)V_lds + v_rd_base(lane);
    bf16x8 sv0[2], sv1[2], sk0[2], sk1[2];
#define SLOAD(i, k0) do { sv0[i] = *(const bf16x8*)(&Vh[(long)((k0) + sr) * LDK + sc]); sv1[i] = *(const bf16x8*)(&Vh[(long)((k0) + 32 + sr) * LDK + sc]); \
    sk0[i] = *(const bf16x8*)(&Kh[(long)((k0) + sr) * LDK + sc]); sk1[i] = *(const bf16x8*)(&Kh[(long)((k0) + 32 + sr) * LDK + sc]); } while (0)
#define SWRITE(off, i) do { *(bf16x8*)((char*)V_lds + (off) + vst0) = sv0[i];          \
    *(bf16x8*)((char*)V_lds + (off) + vst1) = sv1[i]; int kc = sc * 2;               \
    *(bf16x8*)((char*)K_lds + (off) + KSWZ(sr, kc)) = sk0[i];                       \
    *(bf16x8*)((char*)K_lds + (off) + KSWZ(32 + sr, kc)) = sk1[i]; } while (0)
#define SWAIT() asm volatile("s_waitcnt vmcnt(4)" ::: "memory")
#define RESC(a) do { if (__any((a) < 1.f)) { if (hi == 0) al_l[r32] = (a); asm volatile("s_waitcnt lgkmcnt(0)" ::: "memory"); \
    _Pragma("unroll") for (int d = 0; d < 4; ++d) _Pragma("unroll") for (int r = 0; r < 16; ++r) o[d][r] *= al_l[crow(r, hi)]; } } while (0)
    f32x16 pA0, pA1, pB0, pB1; float mnA, mnB, alA, alB; bf16x8 pa0, pa1, pa2, pa3; const int NT = seq / KVBLK;
    SLOAD(0, 0); asm volatile("s_waitcnt vmcnt(0)" ::: "memory"); SWRITE(0, 0); __syncthreads();
    qkt(pA0, pA1, K_lds, qr, r32, hi); partialSM(pA0, pA1, m_reg, mnA, alA);
    SLOAD(1, KVBLK); if (2 < NT) SLOAD(0, 2 * KVBLK);
    SWAIT(); SWRITE((int)SHM_K, 1); __syncthreads();
    int oq = (int)SHM_K, ov = 0, ow = 2 * (int)SHM_K;
    for (int j = 1; j + 1 < NT; j += 2) {
        qkt(pB0, pB1, (bf16_t*)((char*)K_lds + oq), qr, r32, hi);
        finishSM(pA0, pA1, alA, l_reg, pa0, pa1, pa2, pa3);
        SLOAD(1, (j + 2) * KVBLK);
        pv_d0(o, vb0 + ov, pa0, pa1, pa2, pa3); partialSM(pB0, pB1, m_reg, mnB, alB);
        SWAIT(); SWRITE(ow, 0);
        RESC(alB); __syncthreads();
        { const int t_ = ov; ov = oq; oq = ow; ow = t_; }
        qkt(pA0, pA1, (bf16_t*)((char*)K_lds + oq), qr, r32, hi);
        finishSM(pB0, pB1, alB, l_reg, pa0, pa1, pa2, pa3);
        if (j + 3 < NT) SLOAD(0, (j + 3) * KVBLK);
        pv_d0(o, vb0 + ov, pa0, pa1, pa2, pa3); partialSM(pA0, pA1, m_reg, mnA, alA);
        SWAIT(); SWRITE(ow, 1);
        RESC(alA); __syncthreads();
        { const int t_ = ov; ov = oq; oq = ow; ow = t_; }
    }
    SBAR(); qkt(pB0, pB1, (bf16_t*)((char*)K_lds + oq), qr, r32, hi);
    finishSM(pA0, pA1, alA, l_reg, pa0, pa1, pa2, pa3); SBAR();
    pv_d0(o, vb0 + ov, pa0, pa1, pa2, pa3); partialSM(pB0, pB1, m_reg, mnB, alB);
    RESC(alB);
    finishSM(pB0, pB1, alB, l_reg, pa0, pa1, pa2, pa3); SBAR();
    pv_d0(o, vb0 + oq, pa0, pa1, pa2, pa3);
    if (hi == 0) li_l[r32] = l_reg; asm volatile("s_waitcnt lgkmcnt(0)" ::: "memory");
    float rli[16];
#pragma unroll
    for (int r = 0; r < 16; ++r) rli[r] = __builtin_amdgcn_rcpf(li_l[crow(r, hi)]);
    bf16_t* Ow = Ob + (long)(wid * QBLK) * LDO;
    if (!dry)
#pragma unroll
    for (int r = 0; r < 16; ++r) { int orow = crow(r, hi);
#pragma unroll
        for (int d0 = 0; d0 < 4; ++d0) Ow[(long)orow * LDO + d0 * 32 + r32] = (bf16_t)(cvt_pk_bf16(o[d0][r] * rli[r], 0.f) & 0xffffu); }
#undef SLOAD
#undef SWRITE
#undef SWAIT
#undef RESC
}
}

__device__ __forceinline__ void conv_matrix(const float* __restrict__ src, bf16_t* __restrict__ dst, int K, int N, int permmode, float* tile) {
    const int tid = tid_(); const int ntn = N >> 6, ntk = K >> 8, ntiles = ntn * ntk;
    for (int tl = bid_(); tl < ntiles; tl += gridDim.x) {
        const int tk = tl / ntn, tn = tl - tk * ntn, k0 = tk << 8, n0 = tn << 6;
        f32x4 v[8];
#pragma unroll
        for (int i = 0; i < 8; ++i) v[i] = *(const f32x4*)(src + (size_t)(k0 + (tid >> 4) + 32 * i) * N + n0 + (tid & 15) * 4);
#pragma unroll
        for (int i = 0; i < 8; ++i) { float* tp = tile + ((tid >> 4) + 32 * i) * 68 + (tid & 15) * 4; tp[0] = v[i][0]; tp[1] = v[i][1]; tp[2] = v[i][2]; tp[3] = v[i][3]; }
        __syncthreads();
        {
            const int n = tid >> 3, kc = (tid & 7) * 32;
            const bool pm = (permmode & 1) && ((n0 % 3072) < 2048);
            const float qs = ((permmode & 2) && ((n0 % 3072) < 1024)) ? 0.125f * LOG2E : 1.f;
            const int ns = pm ? ((n >> 1) + 32 * (n & 1)) : n;
#pragma unroll
            for (int q = 0; q < 4; ++q) {
                float x[8];
#pragma unroll
                for (int e = 0; e < 8; ++e) x[e] = tile[(kc + q * 8 + e) * 68 + ns] * qs;
                u32x4 w; w.x = cvt_pk_bf16(x[0], x[1]); w.y = cvt_pk_bf16(x[2], x[3]); w.z = cvt_pk_bf16(x[4], x[5]); w.w = cvt_pk_bf16(x[6], x[7]);
                *(u32x4*)(dst + (size_t)(n0 + n) * K + k0 + kc + q * 8) = w;
            }
        }
        __syncthreads();
    }
}

__device__ __forceinline__ void phase_init(PP p, unsigned char* lds) {
    const int tid = tid_(), wid = tid >> 6, lane = tid & 63;
    float* sm = (float*)lds;
    {
        float* rt = (float*)(p->ws + WS_ROPE);
        for (int i = bid_() * NTHREADS + tid; i < 16384 * 32; i += gridDim.x * NTHREADS) {
            const int pos = i >> 5, f = i & 31;
            const float ang = (float)pos * g_inv[f];
            float s, c; sincosf(ang, &s, &c);
            rt[2 * i] = c; rt[2 * i + 1] = s;
        }
    }
    for (int i = tid; i < 6 * 1024; i += NTHREADS) {
        const int s = i >> 10, k = i & 1023;
        const float c = s < 4 ? p->c_prompt[s * 1024 + k] : p->c_sample[(s - 4) * 1024 + k];
        sm[i] = c / (1.f + __expf(-c));
    }
    __syncthreads();
    float* part = sm + 6144;
    for (int u = bid_(); u < 4 * 96; u += gridDim.x) {
        const int l = u / 96, j0 = (u % 96) * 64, c4 = (lane & 15) * 4, kq = lane >> 4;
        const float* wp = p->w_mod + (size_t)l * 1024 * 6144 + (size_t)(wid * 128 + kq) * 6144 + j0 + c4;
        f32x4 a[6];
#pragma unroll
        for (int s6 = 0; s6 < 6; ++s6) a[s6] = (f32x4){0.f, 0.f, 0.f, 0.f};
#pragma unroll 8
        for (int k = 0; k < 32; ++k) {
            const f32x4 w = *(const f32x4*)(wp + (size_t)(4 * k) * 6144); const int kk = wid * 128 + kq + 4 * k;
#pragma unroll
            for (int s6 = 0; s6 < 6; ++s6) a[s6] += w * sm[s6 * 1024 + kk];
        }
#pragma unroll
        for (int s6 = 0; s6 < 6; ++s6)
#pragma unroll
            for (int e = 0; e < 4; ++e) { float v = a[s6][e]; v += __shfl_xor(v, 16); v += __shfl_xor(v, 32); a[s6][e] = v; }
        if (kq == 0) {
#pragma unroll
            for (int s6 = 0; s6 < 6; ++s6) *(f32x4*)(part + (wid * 6 + s6) * 64 + c4) = a[s6];
        }
        __syncthreads();
        if (tid < 384) {
            const int s6 = tid >> 6;
            float v = 0;
#pragma unroll
            for (int w = 0; w < 8; ++w) v += part[(w * 6 + s6) * 64 + lane];
            ((float*)(p->ws + WS_MOD))[(size_t)(s6 * 4 + l) * 6144 + j0 + lane] = v + p->b_mod[l * 6144 + j0 + lane];
        }
        __syncthreads();
    }
    bf16_t* W = (bf16_t*)(p->ws + WS_W);
    float* tile = (float*)lds;
    __syncthreads();
    for (int j = 0; j < 2; ++j) conv_matrix(p->a_w_qkv + (size_t)j * 1024 * 3072, W + W_AQKV + (size_t)j * 3072 * 1024, 1024, 3072, 2, tile);
    for (int j = 0; j < 2; ++j) conv_matrix(p->a_w_o + (size_t)j * 1024 * 1024, W + W_AO + (size_t)j * 1024 * 1024, 1024, 1024, 0, tile);
    conv_matrix(p->b_w_qkv, W + W_BQKV, 1024, 9216, 3, tile);
    conv_matrix(p->b_w_o, W + W_BO, 1024, 1024, 0, tile);
    conv_matrix(p->c_w_qkv, W + W_CQKV, 1024, 1536, 0, tile);
    conv_matrix(p->c_w_o, W + W_CO, 1024, 1024, 0, tile);
    for (int l = 0; l < 4; ++l) conv_matrix(p->mlp_w1 + (size_t)l * 1024 * 4096, W + W_1 + (size_t)l * 4096 * 1024, 1024, 4096, 0, tile);
    for (int l = 0; l < 4; ++l) conv_matrix(p->mlp_w2 + (size_t)l * 4096 * 1024, W + W_2 + (size_t)l * 1024 * 4096, 4096, 1024, 0, tile);
}

__device__ __forceinline__ void phase_modulate(PP p, int layer, int which, int row0, int nrows, int mode) {
    const int tid = tid_(), wid = tid >> 6, lane = tid & 63;
    const int nw = gridDim.x * 8, wg = bid_() * 8 + wid;
    const int rpw = (nrows + nw - 1) / nw;
    int r_lo = wg * rpw, r_hi = r_lo + rpw; if (r_hi > nrows) r_hi = nrows;
    const bool from_input = (layer == 0 && which == 0);
    const float* ng = p->norm_g + (size_t)(layer * 2 + which) * DM;
    bf16_t* H = (bf16_t*)(p->ws + WS_H);
    int cur_s = -1; f32x4 gs[4], sh[4];
#pragma unroll
    for (int k = 0; k < 4; ++k) { gs[k] = (f32x4){0, 0, 0, 0}; sh[k] = (f32x4){0, 0, 0, 0}; }
    constexpr int NR = 3;
    for (int r = r_lo; r < r_hi; r += NR) {
        f32x4 x[NR][4];
#pragma unroll
        for (int q = 0; q < NR; ++q) {
            const int m = row0 + (r + q < r_hi ? r + q : r_hi - 1);
            if (from_input) {
                const float* xr = (m < TP ? p->x_prompt + (size_t)m * DM : p->x_sample + (size_t)(m - TP) * DM) + 8 * lane;
#pragma unroll
                for (int k = 0; k < 2; ++k) { x[q][2 * k] = *(const f32x4*)(xr + 512 * k); x[q][2 * k + 1] = *(const f32x4*)(xr + 512 * k + 4); }
            } else {
                const bf16_t* xr = (const bf16_t*)p->out + (size_t)m * DM + 8 * lane;
#pragma unroll
                for (int k = 0; k < 2; ++k) { const u32x4 ub = *(const u32x4*)(xr + 512 * k);
                    x[q][2 * k] = (f32x4){bf_lo(ub.x), bf_hi(ub.x), bf_lo(ub.y), bf_hi(ub.y)}; x[q][2 * k + 1] = (f32x4){bf_lo(ub.z), bf_hi(ub.z), bf_lo(ub.w), bf_hi(ub.w)}; }
            }
        }
#pragma unroll
        for (int q = 0; q < NR; ++q) {
            if (r + q < r_hi) {
                const int m = row0 + r + q; const int s = seq_of_row(m);
                if (s != cur_s) {
                    cur_s = s;
                    const float* shv = mod_vec(p, s, layer, which * 3 + 0); const float* scv = mod_vec(p, s, layer, which * 3 + 1);
#pragma unroll
                    for (int k = 0; k < 4; ++k) {
                        const int c = 8 * lane + 512 * (k >> 1) + 4 * (k & 1);
                        const f32x4 g = *(const f32x4*)(ng + c), sc = *(const f32x4*)(scv + c);
                        gs[k] = g * (sc + 1.f); sh[k] = *(const f32x4*)(shv + c);
                    }
                }
                float ss = 0;
#pragma unroll
                for (int k = 0; k < 4; ++k) ss += x[q][k][0] * x[q][k][0] + x[q][k][1] * x[q][k][1] + x[q][k][2] * x[q][k][2] + x[q][k][3] * x[q][k][3];
                ss = wave_sum(ss);
                const float rstd = rsqrtf(ss * (1.f / 1024.f) + EPS);
                bf16_t* hp = H + (size_t)m * DM + 8 * lane;
#pragma unroll
                for (int k = 0; k < 2; ++k) {
                    const f32x4 h0 = x[q][2 * k] * rstd * gs[2 * k] + sh[2 * k], h1 = x[q][2 * k + 1] * rstd * gs[2 * k + 1] + sh[2 * k + 1];
                    u32x4 w; w.x = cvt_pk_bf16(h0[0], h0[1]); w.y = cvt_pk_bf16(h0[2], h0[3]); w.z = cvt_pk_bf16(h1[0], h1[1]); w.w = cvt_pk_bf16(h1[2], h1[3]);
                    *(u32x4*)(hp + 512 * k) = w;
                }
            }
        }
    }
}

__device__ __forceinline__ void phase_final(PP p) {
    const int tid = tid_(), wid = tid >> 6, lane = tid & 63;
    const int nw = gridDim.x * 8, wg = bid_() * 8 + wid;
    f32x4 g[4];
#pragma unroll
    for (int k = 0; k < 4; ++k) g[k] = *(const f32x4*)(p->final_g + 4 * lane + 256 * k);
    for (int m = wg; m < T; m += nw) {
        const bf16_t* xr = (const bf16_t*)(p->ws + WS_H) + (size_t)m * DM;
        float* yr = p->out + (size_t)m * DM;
        f32x4 x[4]; float ss = 0;
#pragma unroll
        for (int k = 0; k < 4; ++k) { const u32x2 ub = *(const u32x2*)(xr + 4 * lane + 256 * k); x[k] = (f32x4){bf_lo(ub.x), bf_hi(ub.x), bf_lo(ub.y), bf_hi(ub.y)};
            ss += x[k][0] * x[k][0] + x[k][1] * x[k][1] + x[k][2] * x[k][2] + x[k][3] * x[k][3]; }
        ss = wave_sum(ss);
        const float rstd = rsqrtf(ss * (1.f / 1024.f) + EPS);
#pragma unroll
        for (int k = 0; k < 4; ++k) *(f32x4*)(yr + 4 * lane + 256 * k) = x[k] * rstd * g[k];
    }
}

constexpr int NAT_SLOT = 16384, NAT_TAB = 9 * NAT_SLOT, NAT_MRG = NAT_TAB + 1920, NAT_END = NAT_MRG + 4 * 2560;
__device__ __forceinline__ void phase_natten(PP p, int j, int dry, unsigned char* lds_g) {
    LAS unsigned char* lds = (LAS unsigned char*)lds_g;
    const int tid = tid_(), wid = __builtin_amdgcn_readfirstlane(tid >> 6), lane = tid & 63, fr = lane & 15, fq = lane >> 4;
    bf16_t* QK = (bf16_t*)(p->ws + WS_R);
    const bf16_t* VT = (const bf16_t*)(p->ws + WS_R + R_VT);
    const float* rpb = p->a_rpb + (size_t)j * 16 * 15 * 31;
    const int half = wid >> 2, jq = half ? ((wid & 3) ^ 1) : wid;
    const int krt = 8 * (fr >> 2) + (fr & 3);
    const int qc = 16 * jq + fr; int cs = qc - 8; cs = cs < 0 ? 0 : (cs > 48 ? 48 : cs);
    int cbase = 16 * jq - 8; cbase = cbase < 0 ? 0 : (cbase > 32 ? 32 : cbase);
    const int g8k = (cbase >> 3) + (fr >> 2), g8v = (cbase >> 3) + fq;
    const int laneK = (g8k >> 2) * 4096 + (fq * 16 + 4 * (g8k & 3) + (fr & 3)) * 16;
    const int laneV = 8192 + (g8v >> 2) * 4096 + ((g8v & 3) * 16 + fr) * 16;
    int dco[2][4];
#pragma unroll
    for (int tt = 0; tt < 2; ++tt)
#pragma unroll
        for (int e = 0; e < 4; ++e) { const int kc = cbase + 8 * fq + 4 * tt + e; const bool valid = (kc >= cs) && (kc < cs + 16); dco[tt][e] = (valid ? (kc - qc + 15) : 31) * 4; }
#define NAT_PIECE(kr_, f_) do { const int f2_ = (f_); LAS unsigned char* dst_ = lds + ((kr_) % 9) * NAT_SLOT + f2_ * 1024; \
        if (f2_ < 8) { const int col_ = 32 * (f2_ >> 2) + krt + 4 * ((f2_ >> 1) & 1); \
            __builtin_amdgcn_global_load_lds((const unsigned*)(QK + (size_t)(start + (kr_) * 64 + col_) * LDA_QK + 1024 + h * 64 + 32 * (f2_ & 1) + 8 * fq), (LAS unsigned*)dst_, 16, 0, 0); } \
        else { const int g2_ = f2_ - 8; \
            __builtin_amdgcn_global_load_lds((const unsigned*)(VT + (size_t)(h * 64 + 16 * (fr >> 2) + 4 * (g2_ & 3) + (fr & 3)) * LDA_VT + start + (kr_) * 64 + 32 * (g2_ >> 2) + 8 * fq), (LAS unsigned*)dst_, 16, 0, 0); } \
    } while (0)
    for (int bt = bid_(); bt < 768; bt += (int)gridDim.x) {
        const int band = bt >> 4, h = bt & 15;
        int start, rows, r0;
        if (band < 16) { start = (band >> 2) * 4096; rows = 64; r0 = (band & 3) * 16; }
        else { const int b2 = band - 16; start = TP + (b2 >> 4) * 16384; rows = 256; r0 = (b2 & 15) * 16; }
        if (tid < 480) { const int dc = tid & 31, dr = tid >> 5; *(LAS float*)(lds + NAT_TAB + tid * 4) = dc < 31 ? rpb[(h * 15 + dr) * 31 + dc] * LOG2E : -1e30f; }
        { int rs0 = r0 - 4; rs0 = rs0 < 0 ? 0 : (rs0 > rows - 8 ? rows - 8 : rs0);
#pragma unroll
          for (int f = 0; f < 16; ++f) NAT_PIECE(rs0 + wid, f); }
        bf16_t* qrow = QK + (size_t)(start + r0 * 64 + 16 * jq + fr) * LDA_QK + h * 64;
        bf16x8 q0 = *(const bf16x8*)(qrow + 8 * fq), q1 = *(const bf16x8*)(qrow + 8 * fq + 32);
        u32x4 pw0 = {0u, 0u, 0u, 0u}, pw1 = {0u, 0u, 0u, 0u};
#pragma unroll 1
        for (int r = r0; r < r0 + 16; ++r) {
            int rs = r - 4; rs = rs < 0 ? 0 : (rs > rows - 8 ? rows - 8 : rs);
            asm volatile("s_waitcnt vmcnt(0) lgkmcnt(0)" ::: "memory"); __builtin_amdgcn_s_barrier(); asm volatile("" ::: "memory");
            bf16x8 qn0 = q0, qn1 = q1;
            if (r + 1 < r0 + 16) { qn0 = *(const bf16x8*)(qrow + (size_t)64 * LDA_QK + 8 * fq); qn1 = *(const bf16x8*)(qrow + (size_t)64 * LDA_QK + 8 * fq + 32); }
            if (r + 1 < r0 + 16) { int rsn = r - 3; rsn = rsn < 0 ? 0 : (rsn > rows - 8 ? rows - 8 : rsn);
                if (rsn != rs) { NAT_PIECE(rs + 8, 2 * wid); NAT_PIECE(rs + 8, 2 * wid + 1); } }
            if (half == 0 && r > r0 && !dry) { bf16_t* op = qrow - (size_t)64 * LDA_QK + 16 * fq; *(u32x4*)op = pw0; *(u32x4*)(op + 8) = pw1; }
            f32x4 s[4][2];
            float mx = -1e30f;
#define NAT_LOADK(i_, KF, TV) do { const int kr_ = rs + 4 * half + (i_); \
                const LAS unsigned char* sb_ = lds + (kr_ % 9) * NAT_SLOT + laneK; const LAS unsigned char* tb_ = lds + NAT_TAB + (kr_ - r + 7) * 128; \
                _Pragma("unroll") for (int f = 0; f < 4; ++f) KF[f] = *(const LAS bf16x8*)(sb_ + f * 1024); \
                _Pragma("unroll") for (int tt = 0; tt < 2; ++tt) _Pragma("unroll") for (int e = 0; e < 4; ++e) TV[tt * 4 + e] = *(const LAS float*)(tb_ + dco[tt][e]); } while (0)
#define NAT_SCORE(i_, KF, TV) do { \
                _Pragma("unroll") for (int tt = 0; tt < 2; ++tt) { \
                    f32x4 a_ = {TV[tt * 4], TV[tt * 4 + 1], TV[tt * 4 + 2], TV[tt * 4 + 3]};        \
                    a_ = __builtin_amdgcn_mfma_f32_16x16x32_bf16(KF[tt * 2], q0, a_, 0, 0, 0); \
                    a_ = __builtin_amdgcn_mfma_f32_16x16x32_bf16(KF[tt * 2 + 1], q1, a_, 0, 0, 0); \
                    s[i_][tt] = a_; mx = fmaxf(mx, fmaxf(fmaxf(a_[0], a_[1]), fmaxf(a_[2], a_[3]))); } } while (0)
            {
                bf16x8 kfA[4], kfB[4]; float tvA[8], tvB[8];
                NAT_LOADK(0, kfA, tvA);
                NAT_LOADK(1, kfB, tvB); __builtin_amdgcn_sched_barrier(0);
                NAT_SCORE(0, kfA, tvA); __builtin_amdgcn_sched_barrier(0);
                NAT_LOADK(2, kfA, tvA); __builtin_amdgcn_sched_barrier(0);
                NAT_SCORE(1, kfB, tvB); __builtin_amdgcn_sched_barrier(0);
                NAT_LOADK(3, kfB, tvB); __builtin_amdgcn_sched_barrier(0);
                NAT_SCORE(2, kfA, tvA); __builtin_amdgcn_sched_barrier(0);
                NAT_SCORE(3, kfB, tvB);
            }
#undef NAT_LOADK
#undef NAT_SCORE
            mx = fmaxf(mx, __shfl_xor(mx, 16)); mx = fmaxf(mx, __shfl_xor(mx, 32));
            float l = 0;
            f32x4 o[4];
#pragma unroll
            for (int nt = 0; nt < 4; ++nt) o[nt] = (f32x4){0.f, 0.f, 0.f, 0.f};
#define NAT_LOADV(i_, VF) do { const int kr_ = rs + 4 * half + (i_); const LAS unsigned char* sb_ = lds + (kr_ % 9) * NAT_SLOT + laneV; \
                _Pragma("unroll") for (int f = 0; f < 4; ++f) VF[f] = *(const LAS bf16x8*)(sb_ + f * 1024); } while (0)
#define NAT_PV(i_, VF) do { float pv_[8]; \
                _Pragma("unroll") for (int tt = 0; tt < 2; ++tt) _Pragma("unroll") for (int e = 0; e < 4; ++e) { const float pe_ = __builtin_amdgcn_exp2f(s[i_][tt][e] - mx); pv_[4 * tt + e] = pe_; l += pe_; } \
                u32x4 w_; w_.x = cvt_pk_bf16(pv_[0], pv_[1]); w_.y = cvt_pk_bf16(pv_[2], pv_[3]); w_.z = cvt_pk_bf16(pv_[4], pv_[5]); w_.w = cvt_pk_bf16(pv_[6], pv_[7]); \
                const bf16x8 pa_ = *reinterpret_cast<bf16x8*>(&w_); \
                _Pragma("unroll") for (int nt = 0; nt < 4; ++nt) o[nt] = __builtin_amdgcn_mfma_f32_16x16x32_bf16(VF[nt], pa_, o[nt], 0, 0, 0); } while (0)
            {
                bf16x8 vfA[4], vfB[4];
                NAT_LOADV(0, vfA);
                NAT_LOADV(1, vfB); __builtin_amdgcn_sched_barrier(0);
                NAT_PV(0, vfA); __builtin_amdgcn_sched_barrier(0);
                NAT_LOADV(2, vfA); __builtin_amdgcn_sched_barrier(0);
                NAT_PV(1, vfB); __builtin_amdgcn_sched_barrier(0);
                NAT_LOADV(3, vfB); __builtin_amdgcn_sched_barrier(0);
                NAT_PV(2, vfA); __builtin_amdgcn_sched_barrier(0);
                NAT_PV(3, vfB);
            }
#undef NAT_LOADV
#undef NAT_PV
            l += __shfl_xor(l, 16); l += __shfl_xor(l, 32);
            LAS unsigned* mg = (LAS unsigned*)(lds + NAT_MRG + jq * 2560 + lane * 4);
            if (half == 1) {
                mg[0] = __float_as_uint(mx); mg[64] = __float_as_uint(l);
#pragma unroll
                for (int nt = 0; nt < 4; ++nt) { mg[64 * (2 + 2 * nt)] = cvt_pk_bf16(o[nt][0], o[nt][1]); mg[64 * (3 + 2 * nt)] = cvt_pk_bf16(o[nt][2], o[nt][3]); }
            }
            asm volatile("s_waitcnt lgkmcnt(0)" ::: "memory"); __builtin_amdgcn_s_barrier(); asm volatile("" ::: "memory");
            if (half == 0) {
                const float mx1 = __uint_as_float(mg[0]), l1 = __uint_as_float(mg[64]);
                const float M = fmaxf(mx, mx1), w0 = __builtin_amdgcn_exp2f(mx - M), w1 = __builtin_amdgcn_exp2f(mx1 - M);
                const float rl = 1.f / (l * w0 + l1 * w1), a0 = w0 * rl, a1 = w1 * rl;
                unsigned ow[8];
#pragma unroll
                for (int nt = 0; nt < 4; ++nt) {
                    const unsigned u0 = mg[64 * (2 + 2 * nt)], u1 = mg[64 * (3 + 2 * nt)];
                    ow[2 * nt] = cvt_pk_bf16(o[nt][0] * a0 + bf_lo(u0) * a1, o[nt][1] * a0 + bf_hi(u0) * a1);
                    ow[2 * nt + 1] = cvt_pk_bf16(o[nt][2] * a0 + bf_lo(u1) * a1, o[nt][3] * a0 + bf_hi(u1) * a1);
                }
                pw0 = (u32x4){ow[0], ow[1], ow[2], ow[3]}; pw1 = (u32x4){ow[4], ow[5], ow[6], ow[7]};
            }
            q0 = qn0; q1 = qn1; qrow += (size_t)64 * LDA_QK;
        }
        if (half == 0 && !dry) { bf16_t* op = qrow - (size_t)64 * LDA_QK + 16 * fq; *(u32x4*)op = pw0; *(u32x4*)(op + 8) = pw1; }
        asm volatile("s_waitcnt vmcnt(0) lgkmcnt(0)" ::: "memory"); __builtin_amdgcn_s_barrier(); asm volatile("" ::: "memory");
    }
#undef NAT_PIECE
}

__device__ __forceinline__ void phase_dilated(PP p, int chunk, int dry, unsigned char* lds_g) {
    LAS unsigned char* lds = (LAS unsigned char*)lds_g;
    const int tid = tid_(), wid = __builtin_amdgcn_readfirstlane(tid >> 6), lane = tid & 63, fr = lane & 15, fq = lane >> 4;
    bf16_t* QK3 = (bf16_t*)(p->ws + WS_R);
    const bf16_t* VT3 = (const bf16_t*)(p->ws + WS_R + R_VT);
    float* lse = (float*)(p->ws + WS_LSE);
    const int log2S = chunk == 0 ? 12 : 14;
    const int krt = 8 * (fr >> 2) + (fr & 3);
    const int NTASK = 3 * 16 * 128;
    const int G = (int)gridDim.x, b0 = bid_();
#define DIL_BLK(x_) (((((x_) & 7) << 4) | (((x_) >> 3) & 15)))
#define DIL_FILL(bt_, buf_) do { \
        const int g_ = (bt_) >> 11, rem_ = (bt_) & 2047, h_ = rem_ >> 7, blk_ = DIL_BLK(rem_); \
        const int L_ = 1 << (log2S - 2 * g_), p0b_ = blk_ * 128, u0b_ = p0b_ & (L_ - 1), lb_ = p0b_ - u0b_; \
        const bf16_t* Kg_ = QK3 + g_ * 2048 + 1024 + h_ * 64; \
        const bf16_t* VT_ = VT3 + (size_t)g_ * 1024 * LDB_VT + (size_t)(h_ * 64) * LDB_VT + lb_; \
        const int kb_ = u0b_ - 64 + 32 * wid; \
        LAS unsigned char* dst_ = lds + (buf_) * 65536 + wid * 4096; \
        _Pragma("unroll") for (int tt = 0; tt < 2; ++tt) { \
            int u_ = kb_ + krt + 4 * tt; u_ = u_ < 0 ? 0 : (u_ > L_ - 1 ? L_ - 1 : u_); \
            const bf16_t* kp_ = Kg_ + (size_t)(lb_ + u_) * LDB_QK + 8 * fq; \
            _Pragma("unroll") for (int kk = 0; kk < 2; ++kk) \
                __builtin_amdgcn_global_load_lds((const unsigned*)(kp_ + 32 * kk), (LAS unsigned*)(dst_ + tt * 2048 + kk * 1024), 16, 0, 0); } \
        int uv_ = kb_ + 8 * fq; uv_ = uv_ < 0 ? 0 : (uv_ > L_ - 8 ? L_ - 8 : uv_); \
        _Pragma("unroll") for (int nt = 0; nt < 4; ++nt) \
            __builtin_amdgcn_global_load_lds((const unsigned*)(VT_ + (size_t)(16 * (fr >> 2) + 4 * nt + (fr & 3)) * LDB_VT + uv_), (LAS unsigned*)(dst_ + 32768 + nt * 1024), 16, 0, 0); \
    } while (0)
    const int ddl = -64 - 16 * (wid & 1) + 8 * fq - fr;
    float mb[5][2][4];
#pragma unroll
    for (int ks = 0; ks < 5; ++ks)
#pragma unroll
        for (int tt = 0; tt < 2; ++tt)
#pragma unroll
            for (int e = 0; e < 4; ++e) { const int dd = ddl + 32 * ks + 4 * tt + e; mb[ks][tt][e] = (dd <= 64 && dd >= -64) ? 0.f : -1e30f; }
    if (b0 < NTASK) DIL_FILL(b0, 0);
    int it = 0;
#define DIL_QROW(bt_) (QK3 + ((bt_) >> 11) * 2048 + (((bt_) & 2047) >> 7) * 64 + (size_t)(DIL_BLK(bt_) * 128 + wid * 16 + fr) * LDB_QK)
    bf16x8 q0 = {0, 0, 0, 0, 0, 0, 0, 0}, q1 = q0;
    if (b0 < NTASK) { const bf16_t* qr = DIL_QROW(b0); q0 = *(const bf16x8*)(qr + 8 * fq); q1 = *(const bf16x8*)(qr + 8 * fq + 32); }
    u32x4 pw0 = {0u, 0u, 0u, 0u}, pw1 = pw0;
    for (int bt = b0; bt < NTASK; bt += G, ++it) {
        const int buf = it & 1;
        asm volatile("s_waitcnt vmcnt(0)" ::: "memory"); __builtin_amdgcn_s_barrier(); asm volatile("" ::: "memory");
        const int g = bt >> 11, rem = bt & 2047, h = rem >> 7, blk = DIL_BLK(rem);
        const int L = 1 << (log2S - 2 * g);
        const int p0 = blk * 128 + wid * 16;
        const int u0b = (blk * 128) & (L - 1);
        bf16x8 qn0 = q0, qn1 = q1;
        if (bt + G < NTASK) { const bf16_t* qr = DIL_QROW(bt + G); qn0 = *(const bf16x8*)(qr + 8 * fq); qn1 = *(const bf16x8*)(qr + 8 * fq + 32); }
        if (bt + G < NTASK) DIL_FILL(bt + G, buf ^ 1);
        if (it > 0 && !dry) { bf16_t* op = DIL_QROW(bt - G) + 16 * fq; *(u32x4*)op = pw0; *(u32x4*)(op + 8) = pw1; }
        const int ks0 = wid >> 1;
        const LAS unsigned char* fb = lds + buf * 65536 + ks0 * 4096 + lane * 16;
        const bool edge = (u0b < 64) || (u0b + 192 > L);
        f32x4 s[5][2];
        float mx = -1e30f;
#define DIL_LOADK(ks_, KF) do { _Pragma("unroll") for (int f = 0; f < 4; ++f) KF[f] = *(const LAS bf16x8*)(fb + (ks_) * 4096 + f * 1024); } while (0)
#define DIL_SCORE(ks_, KF) do { _Pragma("unroll") for (int tt = 0; tt < 2; ++tt) { \
            f32x4 a_ = {mb[ks_][tt][0], mb[ks_][tt][1], mb[ks_][tt][2], mb[ks_][tt][3]};     \
            a_ = __builtin_amdgcn_mfma_f32_16x16x32_bf16(KF[tt * 2], q0, a_, 0, 0, 0); \
            a_ = __builtin_amdgcn_mfma_f32_16x16x32_bf16(KF[tt * 2 + 1], q1, a_, 0, 0, 0); \
            _Pragma("unroll") for (int e = 0; e < 4; ++e) { \
                float v_ = a_[e]; \
                if (edge) { const int uk_ = u0b + 16 * wid + fr + ddl + (32 * (ks_) + 4 * tt + e); if (uk_ < 0 || uk_ >= L) v_ = -1e30f; } \
                s[ks_][tt][e] = v_; mx = fmaxf(mx, v_); } } } while (0)
        {
            bf16x8 kfA[4], kfB[4];
            DIL_LOADK(0, kfA);
            DIL_LOADK(1, kfB); __builtin_amdgcn_sched_barrier(0);
            DIL_SCORE(0, kfA); __builtin_amdgcn_sched_barrier(0);
            DIL_LOADK(2, kfA); __builtin_amdgcn_sched_barrier(0);
            DIL_SCORE(1, kfB); __builtin_amdgcn_sched_barrier(0);
            DIL_LOADK(3, kfB); __builtin_amdgcn_sched_barrier(0);
            DIL_SCORE(2, kfA); __builtin_amdgcn_sched_barrier(0);
            DIL_LOADK(4, kfA); __builtin_amdgcn_sched_barrier(0);
            DIL_SCORE(3, kfB); __builtin_amdgcn_sched_barrier(0);
            DIL_SCORE(4, kfA);
        }
#undef DIL_LOADK
#undef DIL_SCORE
        mx = fmaxf(mx, __shfl_xor(mx, 16)); mx = fmaxf(mx, __shfl_xor(mx, 32));
        float l = 0;
        f32x4 o[4];
#pragma unroll
        for (int nt = 0; nt < 4; ++nt) o[nt] = (f32x4){0.f, 0.f, 0.f, 0.f};
#define DIL_LOADV(ks_, VF) do { _Pragma("unroll") for (int f = 0; f < 4; ++f) VF[f] = *(const LAS bf16x8*)(fb + 32768 + (ks_) * 4096 + f * 1024); } while (0)
#define DIL_PV(ks_, VF) do { float pv_[8]; \
            _Pragma("unroll") for (int tt = 0; tt < 2; ++tt) _Pragma("unroll") for (int e = 0; e < 4; ++e) { const float pe_ = __builtin_amdgcn_exp2f(s[ks_][tt][e] - mx); pv_[4 * tt + e] = pe_; l += pe_; } \
            u32x4 w_; w_.x = cvt_pk_bf16(pv_[0], pv_[1]); w_.y = cvt_pk_bf16(pv_[2], pv_[3]); w_.z = cvt_pk_bf16(pv_[4], pv_[5]); w_.w = cvt_pk_bf16(pv_[6], pv_[7]); \
            const bf16x8 pa_ = *reinterpret_cast<bf16x8*>(&w_); \
            _Pragma("unroll") for (int nt = 0; nt < 4; ++nt) o[nt] = __builtin_amdgcn_mfma_f32_16x16x32_bf16(VF[nt], pa_, o[nt], 0, 0, 0); } while (0)
        {
            bf16x8 vfA[4], vfB[4];
            DIL_LOADV(0, vfA);
            DIL_LOADV(1, vfB); __builtin_amdgcn_sched_barrier(0);
            DIL_PV(0, vfA); __builtin_amdgcn_sched_barrier(0);
            DIL_LOADV(2, vfA); __builtin_amdgcn_sched_barrier(0);
            DIL_PV(1, vfB); __builtin_amdgcn_sched_barrier(0);
            DIL_LOADV(3, vfB); __builtin_amdgcn_sched_barrier(0);
            DIL_PV(2, vfA); __builtin_amdgcn_sched_barrier(0);
            DIL_LOADV(4, vfA); __builtin_amdgcn_sched_barrier(0);
            DIL_PV(3, vfB); __builtin_amdgcn_sched_barrier(0);
            DIL_PV(4, vfA);
        }
#undef DIL_LOADV
#undef DIL_PV
        l += __shfl_xor(l, 16); l += __shfl_xor(l, 32);
        const float rl = 1.f / l;
        if (fq == 0 && !dry) lse[((size_t)g * 16384 + p0 + fr) * 16 + h] = mx + __log2f(l);
        u32x4 w0, w1;
        w0.x = cvt_pk_bf16(o[0][0] * rl, o[0][1] * rl); w0.y = cvt_pk_bf16(o[0][2] * rl, o[0][3] * rl); w0.z = cvt_pk_bf16(o[1][0] * rl, o[1][1] * rl); w0.w = cvt_pk_bf16(o[1][2] * rl, o[1][3] * rl);
        w1.x = cvt_pk_bf16(o[2][0] * rl, o[2][1] * rl); w1.y = cvt_pk_bf16(o[2][2] * rl, o[2][3] * rl); w1.z = cvt_pk_bf16(o[3][0] * rl, o[3][1] * rl); w1.w = cvt_pk_bf16(o[3][2] * rl, o[3][3] * rl);
        pw0 = w0; pw1 = w1; q0 = qn0; q1 = qn1;
    }
    if (it > 0 && !dry) { bf16_t* op = DIL_QROW(b0 + (it - 1) * G) + 16 * fq; *(u32x4*)op = pw0; *(u32x4*)(op + 8) = pw1; }
#undef DIL_FILL
#undef DIL_QROW
#undef DIL_BLK
    asm volatile("s_waitcnt vmcnt(0)" ::: "memory"); __builtin_amdgcn_s_barrier();
}

__device__ __forceinline__ void phase_merge(PP p, int chunk) {
    const bf16_t* QK3 = (const bf16_t*)(p->ws + WS_R);
    const float* lse = (const float*)(p->ws + WS_LSE);
    bf16_t* Om = (bf16_t*)(p->ws + WS_H) + (size_t)chunk * 16384 * DM;
    const int log2S = chunk == 0 ? 12 : 14; const int Smask = (1 << log2S) - 1;
    for (int it = bid_() * NTHREADS + tid_(); it < 16384 * 64; it += gridDim.x * NTHREADS) {
        const int n = it >> 6, hq = it & 63, h = hq >> 2;
        const int sb = n >> log2S, t = n & Smask;
        int pg[3]; float ls[3];
#pragma unroll
        for (int g = 0; g < 3; ++g) {
            const int ld = 2 * g;
            pg[g] = (sb << log2S) + ((t & ((1 << ld) - 1)) << (log2S - ld)) + (t >> ld);
            ls[g] = lse[((size_t)g * 16384 + pg[g]) * 16 + h];
        }
        const float mx = fmaxf(ls[0], fmaxf(ls[1], ls[2]));
        float w[3]; w[0] = __builtin_amdgcn_exp2f(ls[0] - mx); w[1] = __builtin_amdgcn_exp2f(ls[1] - mx); w[2] = __builtin_amdgcn_exp2f(ls[2] - mx);
        const float inv = 1.f / (w[0] + w[1] + w[2]);
        float acc[16];
#pragma unroll
        for (int e = 0; e < 16; ++e) acc[e] = 0.f;
#pragma unroll
        for (int g = 0; g < 3; ++g) {
            const bf16_t* op = QK3 + (size_t)pg[g] * LDB_QK + g * 2048 + hq * 16;
            const u32x4 a = *(const u32x4*)op, b = *(const u32x4*)(op + 8);
            const float wg = w[g] * inv;
            acc[0] += wg * bf_lo(a.x); acc[1] += wg * bf_hi(a.x); acc[2] += wg * bf_lo(a.y); acc[3] += wg * bf_hi(a.y);
            acc[4] += wg * bf_lo(a.z); acc[5] += wg * bf_hi(a.z); acc[6] += wg * bf_lo(a.w); acc[7] += wg * bf_hi(a.w);
            acc[8] += wg * bf_lo(b.x); acc[9] += wg * bf_hi(b.x); acc[10] += wg * bf_lo(b.y); acc[11] += wg * bf_hi(b.y);
            acc[12] += wg * bf_lo(b.z); acc[13] += wg * bf_hi(b.z); acc[14] += wg * bf_lo(b.w); acc[15] += wg * bf_hi(b.w);
        }
        u32x4 o0, o1;
        o0.x = cvt_pk_bf16(acc[0], acc[1]); o0.y = cvt_pk_bf16(acc[2], acc[3]); o0.z = cvt_pk_bf16(acc[4], acc[5]); o0.w = cvt_pk_bf16(acc[6], acc[7]);
        o1.x = cvt_pk_bf16(acc[8], acc[9]); o1.y = cvt_pk_bf16(acc[10], acc[11]); o1.z = cvt_pk_bf16(acc[12], acc[13]); o1.w = cvt_pk_bf16(acc[14], acc[15]);
        bf16_t* dst = Om + (size_t)n * DM + hq * 16;
        *(u32x4*)dst = o0; *(u32x4*)(dst + 8) = o1;
    }
}

struct QknTok { u32x4 ua0, ub0, ua1, ub1; f32x4 cs[4]; };
__device__ __forceinline__ void qkn_load(bf16_t* QKV, const float* rope, int m, int hs, int half, int c, QknTok& q) {
    const int t = m < TP ? (m & 4095) : ((m - TP) & 16383);
    const int pos = half ? (t & 63) : (t >> 6);
    const float* tp = rope + ((size_t)pos * 32 + 8 * c) * 2;
#pragma unroll
    for (int e = 0; e < 4; ++e) q.cs[e] = *(const f32x4*)(tp + 4 * e);
    const bf16_t* xp = QKV + (size_t)m * 1536 + hs * 128 + half * 64 + 8 * c;
    q.ua0 = *(const u32x4*)xp; q.ub0 = *(const u32x4*)(xp + 32);
    q.ua1 = q.ua0; q.ub1 = q.ub0;
    if (hs < 2) { q.ua1 = *(const u32x4*)(xp + 1024); q.ub1 = *(const u32x4*)(xp + 1024 + 32); }
}
__device__ __forceinline__ void qkn_one(bf16_t* xp, const u32x4 ua, const u32x4 ub, const f32x4 (&cs)[4], const f32x4 (&g)[4]) {
    float a[8], b[8];
    a[0] = bf_lo(ua.x); a[1] = bf_hi(ua.x); a[2] = bf_lo(ua.y); a[3] = bf_hi(ua.y); a[4] = bf_lo(ua.z); a[5] = bf_hi(ua.z); a[6] = bf_lo(ua.w); a[7] = bf_hi(ua.w);
    b[0] = bf_lo(ub.x); b[1] = bf_hi(ub.x); b[2] = bf_lo(ub.y); b[3] = bf_hi(ub.y); b[4] = bf_lo(ub.z); b[5] = bf_hi(ub.z); b[6] = bf_lo(ub.w); b[7] = bf_hi(ub.w);
    float ss = 0;
#pragma unroll
    for (int e = 0; e < 8; ++e) ss += a[e] * a[e] + b[e] * b[e];
    ss += __shfl_xor(ss, 1); ss += __shfl_xor(ss, 2); ss += __shfl_xor(ss, 4);
    const float rstd = rsqrtf(ss * (1.f / 128.f) + EPS);
    float ra[8], rb[8];
#pragma unroll
    for (int e = 0; e < 8; ++e) {
        const float xa = a[e] * rstd * g[e >> 2][e & 3], xb = b[e] * rstd * g[2 + (e >> 2)][e & 3];
        const float co = cs[e >> 1][(e & 1) * 2], si = cs[e >> 1][(e & 1) * 2 + 1];
        ra[e] = xa * co - xb * si; rb[e] = xa * si + xb * co;
    }
    u32x4 wa, wb;
    wa.x = cvt_pk_bf16(ra[0], ra[1]); wa.y = cvt_pk_bf16(ra[2], ra[3]); wa.z = cvt_pk_bf16(ra[4], ra[5]); wa.w = cvt_pk_bf16(ra[6], ra[7]);
    wb.x = cvt_pk_bf16(rb[0], rb[1]); wb.y = cvt_pk_bf16(rb[2], rb[3]); wb.z = cvt_pk_bf16(rb[4], rb[5]); wb.w = cvt_pk_bf16(rb[6], rb[7]);
    *(u32x4*)xp = wa; *(u32x4*)(xp + 32) = wb;
}
__device__ __forceinline__ void qkn_finish(bf16_t* QKV, int m, int hs, int half, int c, const QknTok& q, const f32x4 (&gq)[4], const f32x4 (&gk)[4]) {
    bf16_t* xp = QKV + (size_t)m * 1536 + hs * 128 + half * 64 + 8 * c;
    qkn_one(xp, q.ua0, q.ub0, q.cs, gq);
    if (hs < 2) qkn_one(xp + 1024, q.ua1, q.ub1, q.cs, gk);
}
__device__ __forceinline__ void phase_qknorm(PP p) {
    const int tid = tid_(), wid = tid >> 6, lane = tid & 63;
    const int nw = gridDim.x * 8, wg = bid_() * 8 + wid;
    bf16_t* QKV = (bf16_t*)(p->ws + WS_R);
    const float* rope = (const float*)(p->ws + WS_ROPE);
    const int hs = lane >> 3, half = (lane >> 2) & 1, c = lane & 3;
    f32x4 gq[4], gk[4];
    { const float* gv = p->c_q_g + half * 64 + 8 * c; gq[0] = *(const f32x4*)gv; gq[1] = *(const f32x4*)(gv + 4); gq[2] = *(const f32x4*)(gv + 32); gq[3] = *(const f32x4*)(gv + 36); }
    { const float* gv = p->c_k_g + half * 64 + 8 * c; gk[0] = *(const f32x4*)gv; gk[1] = *(const f32x4*)(gv + 4); gk[2] = *(const f32x4*)(gv + 32); gk[3] = *(const f32x4*)(gv + 36); }
    for (int m = wg; m < T; m += 2 * nw) {
        QknTok A, B;
        const bool hb = m + nw < T;
        qkn_load(QKV, rope, m, hs, half, c, A);
        qkn_load(QKV, rope, hb ? m + nw : m, hs, half, c, B);
        __builtin_amdgcn_sched_barrier(0);
        qkn_finish(QKV, m, hs, half, c, A, gq, gk);
        if (hb) qkn_finish(QKV, m + nw, hs, half, c, B, gq, gk);
    }
}

__device__ __forceinline__ void phase_attn_c(PP p, unsigned char* lds, int dry) {
    const bf16_t* QKV = (const bf16_t*)(p->ws + WS_R);
    bf16_t* O = (bf16_t*)(p->ws + WS_R + 144 * MiB);
    for (int u = bid_(); u < 1536; u += gridDim.x) {
        int start, len, h, qb;
        if (u < 1024) { const int sb = u >> 9; h = (u >> 6) & 7; qb = u & 63; start = TP + sb * 16384; len = 16384; }
        else { const int v = u - 1024; const int sb = v >> 7; h = (v >> 4) & 7; qb = v & 15; start = sb * 4096; len = 4096; }
        const size_t q0 = (size_t)(start + qb * 256);
        att::attn_dense_body(QKV + q0 * 1536 + h * 128, QKV + (size_t)start * 1536 + 1024 + (h >> 2) * 128, QKV + (size_t)start * 1536 + 1280 + (h >> 2) * 128,
                             O + q0 * 1024 + h * 128, len, (char*)lds, dry);
        __syncthreads();
    }
}

__device__ __forceinline__ bool gemm_job(PP p, const Ph ph, int jn, pg8::Gemm& g, pg8::Epi& e) {
    const bf16_t* W = (const bf16_t*)(p->ws + WS_W);
    const bf16_t* H = (const bf16_t*)(p->ws + WS_H);
    bf16_t* Rb = (bf16_t*)(p->ws + WS_R);
    e.mode = 0; e.O = nullptr; e.ldc = 0; e.log2L = 0; e.log2d = 0; e.rope = (const float*)(p->ws + WS_ROPE); e.base_p = nullptr; e.base_s = nullptr; e.baseb = (const bf16_t*)p->out; e.outb = (bf16_t*)p->out; e.gate = nullptr; e.row_off = 0;
    g.lda = 1024; g.ldb = 1024; g.K = 1024; g.pA_L = -1; g.pA_d = 0; g.pA_S = 0; g.pB_L = -1; g.pB_d = 0; g.pB_S = 0;
    const int type = ph.type & 0xff;
    if (type == PH_QKV_A) {
        const bf16_t* Wq = W + W_AQKV + (size_t)ph.a * 3072 * 1024;
        if (jn == 0) { g.A = H; g.Bt = Wq; g.M = T; g.N = 2048; e.O = Rb; e.ldc = LDA_QK; return true; }
        if (jn == 1) { g.A = Wq + (size_t)2048 * 1024; g.Bt = H; g.M = 1024; g.N = T; e.O = Rb + R_VT / 2; e.ldc = LDA_VT; return true; }
        return false;
    }
    if (type == PH_WO) {
        if (jn != 0) return false;
        e.mode = 3; e.gate = (const float*)(p->ws + WS_MOD) + ((size_t)ph.a * 6 + 2) * DM;
        if (ph.a == 0) { e.base_p = p->x_prompt; e.base_s = p->x_sample; }
        g.N = 1024;
        if (ph.b == 0) { g.A = Rb; g.lda = LDA_QK; g.Bt = W + W_AO + (size_t)ph.c * 1024 * 1024; g.M = T; }
        else if (ph.b == 1) { g.A = H; g.Bt = W + W_BO; g.M = T; }
        else { g.A = Rb + (size_t)72 * MiB; g.Bt = W + W_CO; g.M = T; }
        return true;
    }
    if (type == PH_MLP) {
        const int step = ph.b;
        const bool has_down = step >= 1, has_up = step <= 2;
        const int which = (jn == 0) ? (has_down ? 0 : 1) : ((jn == 1 && has_down && has_up) ? 1 : 2);
        if (which == 0) {
            const int c = step - 1;
            e.mode = 3; e.gate = (const float*)(p->ws + WS_MOD) + ((size_t)ph.a * 6 + 5) * DM; e.row_off = c * 16384;
            if (ph.a == 3) e.outb = (bf16_t*)(p->ws + WS_H);
            g.A = Rb + (size_t)(c & 1) * 70 * MiB; g.lda = LDU; g.Bt = W + W_2 + (size_t)ph.a * 1024 * 4096; g.ldb = 4096; g.M = 16384; g.N = 1024; g.K = 4096;
            return true;
        }
        if (which == 1) {
            const int c = step;
            e.mode = 2; e.O = Rb + (size_t)(c & 1) * 70 * MiB; e.ldc = LDU;
            g.A = H + (size_t)c * 16384 * 1024; g.Bt = W + W_1 + (size_t)ph.a * 4096 * 1024; g.M = 16384; g.N = 4096;
            return true;
        }
        return false;
    }
    if (type == PH_QKV_B) {
        if (jn >= 6) return false;
        const int gi = jn >> 1;
        const int log2S = ph.c == 0 ? 12 : 14, log2d = 2 * gi, log2L = log2S - log2d;
        const bf16_t* Hc = H + (size_t)ph.c * 16384 * 1024;
        const bf16_t* Wg = W + W_BQKV + (size_t)gi * 3072 * 1024;
        if ((jn & 1) == 0) { e.mode = 1; e.O = Rb + gi * 2048; e.ldc = LDB_QK; e.log2d = log2d; e.log2L = log2L;
            g.A = Hc; g.lda = 1024 << log2d; g.pA_L = log2L; g.pA_d = log2d; g.pA_S = log2S; g.Bt = Wg; g.M = 16384; g.N = 2048; }
        else { e.O = Rb + R_VT / 2 + (size_t)gi * 1024 * LDB_VT; e.ldc = LDB_VT; g.A = Wg + (size_t)2048 * 1024;
            g.Bt = Hc; g.ldb = 1024 << log2d; g.pB_L = log2L; g.pB_d = log2d; g.pB_S = log2S; g.M = 1024; g.N = 16384; }
        return true;
    }
    if (type == PH_QKV_C) {
        if (jn != 0) return false;
        g.A = H; g.Bt = W + W_CQKV; g.M = T; g.N = 1536; e.O = Rb; e.ldc = 1536; return true;
    }
    return false;
}

__device__ __forceinline__ void run_phase(PP p, const Ph ph, unsigned char* lds) {
    const int type = ph.type & 0xff; const int dry = ph.type >> 8;
    if (type == PH_QKV_A || type == PH_WO || type == PH_MLP || type == PH_QKV_B || type == PH_QKV_C) {
#pragma unroll 1
        for (int jn = 0; jn < 6; ++jn) {
            pg8::Gemm g; pg8::Epi e;
            if (!gemm_job(p, ph, jn, g, e)) break;
            e.dry = dry;
            pg8::StaticOrder S; S.init(g.M, g.N, (int)gridDim.x, bid_());
            pg8::gemm_phase((LAS unsigned char*)lds, g, S, e);
        }
        return;
    }
    switch (type) {
    case PH_INIT: phase_init(p, lds); break;
    case PH_MOD:
        if (ph.c < 0) phase_modulate(p, ph.a, ph.b, 0, T, 0); else phase_modulate(p, ph.a, ph.b, ph.c * 16384, 16384, 1);
        break;
    case PH_NATTEN: phase_natten(p, ph.a, dry, lds); break;
    case PH_DIL: phase_dilated(p, ph.c, dry, lds); break;
    case PH_MERGE: phase_merge(p, ph.c); break;
    case PH_QKNORM: phase_qknorm(p); break;
    case PH_ATTN_C: phase_attn_c(p, lds, dry); break;
    case PH_FINAL: phase_final(p); break;
    default: break;
    }
}


#define XB_TMO      128
#define XB_XCNT(j)  (256  + 64 * (j))
#define XB_XSUB(j)  (1280 + 64 * (j))
#define XB_XGEN(j)  (2304 + 64 * (j))
#define XB_TOP      3328
#define XB_TOPGEN   3392
#define XCD_BAR_WORDS 3456
#define XB_SPIN_CAP (1u << 22)
__device__ __forceinline__ unsigned xb_ld(unsigned* p)              { return __hip_atomic_load(p, __ATOMIC_RELAXED, __HIP_MEMORY_SCOPE_AGENT); }
__device__ __forceinline__ unsigned xb_add(unsigned* p, unsigned v) { return __hip_atomic_fetch_add(p, v, __ATOMIC_RELAXED, __HIP_MEMORY_SCOPE_AGENT); }
__device__ __forceinline__ unsigned xb_xcc_id() { return (unsigned)__builtin_amdgcn_s_getreg((3 << 11) | 20) & 0xFu; }
#define XB_SPIN(cond, bar) do { unsigned _sp = 0; while (cond) { __builtin_amdgcn_s_sleep(1); \
    if ((++_sp & 255u) == 0u) { if (xb_ld(&(bar)[XB_TMO])) break; if (_sp > XB_SPIN_CAP) { atomicAdd(&(bar)[XB_TMO], 1u); break; } } } } while (0)
__device__ __forceinline__ void xcd_barrier_complete(unsigned* bar, unsigned x, unsigned& nloc, unsigned& nx) {
    const unsigned G = gridDim.x;
    unsigned sum, cnt, mine, sp = 0u;
    for (;;) {
        sum = 0u; cnt = 0u; mine = 0u;
#pragma unroll
        for (unsigned j = 0; j < 16; ++j) { const unsigned c = xb_ld(&bar[XB_XCNT(j)]); sum += c; cnt += (c > 0u) ? 1u : 0u; mine = (j == x) ? c : mine; }
        if (sum == G) break;
        __builtin_amdgcn_s_sleep(1);
        if ((++sp & 255u) == 0u) { if (xb_ld(&bar[XB_TMO])) break; if (sp > XB_SPIN_CAP) { atomicAdd(&bar[XB_TMO], 1u); break; } }
    }
    nloc = mine > 0u ? mine : 1u; nx = cnt > 0u ? cnt : 1u;
}
__device__ __forceinline__ void xcd_barrier(unsigned* bar, volatile LAS unsigned* st) {
    asm volatile("s_waitcnt vmcnt(0)" ::: "memory");
    __syncthreads();
    if (threadIdx.x == 0) {
        const unsigned x = xb_xcc_id();
        __builtin_amdgcn_s_waitcnt(0);
        unsigned nloc = st[0], nx = st[1];
        if (nloc == 0u) { xcd_barrier_complete(bar, x, nloc, nx); st[0] = nloc; st[1] = nx; }
        const unsigned old = xb_add(&bar[XB_XSUB(x)], 1u);
        const unsigned gen = old / nloc;
        if (old + 1u == (gen + 1u) * nloc) {
            __builtin_amdgcn_fence(__ATOMIC_RELEASE, "agent");
            asm volatile("s_waitcnt vmcnt(0)" ::: "memory");
            const unsigned og = xb_add(&bar[XB_TOP], 1u);
            const unsigned tg = og / nx;
            if (og + 1u == (tg + 1u) * nx) xb_add(&bar[XB_TOPGEN], 1u);
            else XB_SPIN(xb_ld(&bar[XB_TOPGEN]) == tg, bar);
            __builtin_amdgcn_fence(__ATOMIC_ACQUIRE, "agent");
            xb_add(&bar[XB_XGEN(x)], 1u);
            asm volatile("s_waitcnt vmcnt(0)" ::: "memory");
        } else {
            XB_SPIN(xb_ld(&bar[XB_XGEN(x)]) == gen, bar);
            __builtin_amdgcn_fence(__ATOMIC_ACQUIRE, "agent");
            asm volatile("s_waitcnt vmcnt(0)" ::: "memory");
        }
    }
    __syncthreads();
}

__global__ void __launch_bounds__(NTHREADS, 2) mk_fwd(Params p, int ph0, int ph1) {
    extern __shared__ __attribute__((aligned(16))) unsigned char lds[];
    cg::grid_group grid = cg::this_grid();
    volatile LAS unsigned* st = (volatile LAS unsigned*)((LAS unsigned char*)lds + (LDS_BYTES - 16));
    if (threadIdx.x == 0) { st[0] = 0u; st[1] = 0u; }
    __syncthreads();
    if (ph1 - ph0 > 1 && threadIdx.x == 0) (void)xb_add((unsigned*)(p.ws + WS_BAR) + XB_XCNT(xb_xcc_id()), 1u);
    for (int i = ph0; i < ph1; ++i) {
        run_phase(params_(), g_tab.v[i], lds);
        if (i + 1 < ph1) {
            if (p.nph < 0) { __syncthreads(); grid.sync(); }
            xcd_barrier((unsigned*)(params_()->ws + WS_BAR), st);
        }
    }
}


extern "C" void kernel_launch(void* const* d_in, const int* in_sizes, int n_in, void* d_out, int out_size, void* d_ws, size_t ws_size, hipStream_t stream) {
    static int grid = 0;
    if (grid == 0) {
        if (n_in != 19 || out_size != T * DM || ws_size < WS_END) { fprintf(stderr, "kernel_launch: unexpected shapes: n_in %d out %d ws %zu\n", n_in, out_size, ws_size); grid = -1; return; }
        int dev = 0, cus = 0, per_cu = 0;
        hipGetDevice(&dev); hipDeviceGetAttribute(&cus, hipDeviceAttributeMultiprocessorCount, dev);
        if (hipFuncSetAttribute((const void*)mk_fwd, hipFuncAttributeMaxDynamicSharedMemorySize, LDS_BYTES) != hipSuccess) { fprintf(stderr, "kernel_launch: hipFuncSetAttribute failed\n"); grid = -1; return; }
        if (hipOccupancyMaxActiveBlocksPerMultiprocessor(&per_cu, (const void*)mk_fwd, NTHREADS, LDS_BYTES) != hipSuccess || per_cu < 1) { fprintf(stderr, "kernel_launch: occupancy query says %d\n", per_cu); per_cu = 1; }
        (void)hipGetLastError();
        grid = cus * per_cu;
    }
    if (grid < 0) return;
    Params p{};
    p.x_prompt = (const float*)d_in[0]; p.x_sample = (const float*)d_in[1]; p.c_prompt = (const float*)d_in[2]; p.c_sample = (const float*)d_in[3];
    p.w_mod = (const float*)d_in[4]; p.b_mod = (const float*)d_in[5]; p.norm_g = (const float*)d_in[6]; p.final_g = (const float*)d_in[7];
    p.a_w_qkv = (const float*)d_in[8]; p.a_rpb = (const float*)d_in[9]; p.a_w_o = (const float*)d_in[10]; p.b_w_qkv = (const float*)d_in[11]; p.b_w_o = (const float*)d_in[12];
    p.c_w_qkv = (const float*)d_in[13]; p.c_q_g = (const float*)d_in[14]; p.c_k_g = (const float*)d_in[15]; p.c_w_o = (const float*)d_in[16]; p.mlp_w1 = (const float*)d_in[17]; p.mlp_w2 = (const float*)d_in[18];
    p.out = (float*)d_out; p.ws = (unsigned char*)d_ws; p.nph = 0; p.pad = 0;
    if (hipMemsetAsync((char*)d_ws + WS_BAR, 0, XCD_BAR_WORDS * 4, stream) != hipSuccess) { fprintf(stderr, "kernel_launch: memset of barrier words failed\n"); return; }
    p.nph = H_TAB.n;
#if MK_MULTI
    for (int i = 0; i < p.nph; ++i) hipLaunchKernelGGL(mk_fwd, dim3(grid), dim3(NTHREADS), LDS_BYTES, stream, p, i, i + 1);
#else
    int ph0 = 0, ph1 = p.nph;
    void* args[] = {&p, &ph0, &ph1};
    hipError_t e = hipLaunchCooperativeKernel((const void*)mk_fwd, dim3(grid), dim3(NTHREADS), args, LDS_BYTES, stream);
    if (e != hipSuccess) fprintf(stderr, "kernel_launch: cooperative launch failed: %s (grid %d)\n", hipGetErrorString(e), grid);
#endif
}
```

```cpp
#include <hip/hip_runtime.h>
#include <hip/hip_cooperative_groups.h>
#include <cstdio>
#include <cstdint>
#include <cmath>
namespace cg = cooperative_groups;

#ifndef MK_MULTI
#define MK_MULTI 0
#endif

#define LAS __attribute__((address_space(3)))
typedef unsigned short bf16_t;
typedef short bf16x8 __attribute__((ext_vector_type(8)));
typedef short s16x4 __attribute__((ext_vector_type(4)));
typedef float f32x4 __attribute__((ext_vector_type(4)));
typedef float f32x8 __attribute__((ext_vector_type(8)));
typedef float f32x16 __attribute__((ext_vector_type(16)));
typedef unsigned u32x4 __attribute__((ext_vector_type(4)));
typedef unsigned u32x2 __attribute__((ext_vector_type(2)));

constexpr int T = 49152;
constexpr int TP = 16384;
constexpr int DM = 1024, FF = 4096;
constexpr float EPS = 1e-6f;
constexpr float LOG2E = 1.4426950408889634f;
constexpr int NTHREADS = 512;

constexpr size_t MiB = 1048576;
constexpr size_t WS_W = 0;
constexpr size_t WS_MOD = 105 * MiB;
constexpr size_t WS_BAR = 105 * MiB + 768 * 1024;
constexpr size_t WS_ROPE = 106 * MiB;
constexpr size_t WS_LSE = 110 * MiB;
constexpr size_t WS_H = 113 * MiB;
constexpr size_t WS_R = 209 * MiB;
constexpr size_t R_VT = 205 * MiB;
constexpr int LDA_QK = 2048 + 128;
constexpr int LDA_VT = T + 128;
constexpr int LDB_QK = 6144 + 128;
constexpr int LDB_VT = 16384 + 128;
constexpr int LDU = 4096 + 128;
constexpr size_t WS_END = 512 * MiB;
constexpr size_t W_AQKV = 0;
constexpr size_t W_AO = 6291456;
constexpr size_t W_BQKV = 8388608;
constexpr size_t W_BO = 17825792;
constexpr size_t W_CQKV = 18874368;
constexpr size_t W_CO = 20447232;
constexpr size_t W_1 = 21495808;
constexpr size_t W_2 = 38273024;
constexpr int LDS_BYTES = 159744;

struct Ph { short type, a, b, c; };
enum { PH_INIT = 0, PH_MOD, PH_QKV_A, PH_NATTEN, PH_WO, PH_MLP, PH_QKV_B, PH_DIL, PH_MERGE, PH_QKV_C, PH_QKNORM, PH_ATTN_C, PH_FINAL };
constexpr int MAXPH = 96;
struct Params {
    const float *x_prompt, *x_sample, *c_prompt, *c_sample, *w_mod, *b_mod, *norm_g, *final_g, *a_w_qkv, *a_rpb, *a_w_o, *b_w_qkv, *b_w_o,
        *c_w_qkv, *c_q_g, *c_k_g, *c_w_o, *mlp_w1, *mlp_w2;
    float* out; unsigned char* ws;
    int nph, pad;
};
struct PhTab { Ph v[MAXPH]; int n; };
#ifndef PROBE_DRYBIT
#define PROBE_DRYBIT 0x100
#endif
#ifndef PROBE_MASK
#define PROBE_MASK 0
#endif
constexpr void tab_add1(PhTab& t, int type, int a, int b, int c) { t.v[t.n].type = (short)type; t.v[t.n].a = (short)a; t.v[t.n].b = (short)b; t.v[t.n].c = (short)c; t.n++; }
constexpr void tab_add(PhTab& t, int type, int a, int b, int c) { if ((PROBE_MASK >> type) & 1) tab_add1(t, type | PROBE_DRYBIT, a, b, c); tab_add1(t, type, a, b, c); }
constexpr PhTab make_tab() {
    PhTab t{};
    tab_add(t, PH_INIT, 0, 0, 0);
    for (int layer = 0; layer < 4; ++layer) {
        const int kind = layer % 3, j = layer / 3;
        if (kind == 0) {
            tab_add(t, PH_MOD, layer, 0, -1); tab_add(t, PH_QKV_A, j, 0, 0); tab_add(t, PH_NATTEN, j, 0, 0); tab_add(t, PH_WO, layer, 0, j);
        } else if (kind == 1) {
            tab_add(t, PH_MOD, layer, 0, -1);
            for (int c = 0; c < 3; ++c) { tab_add(t, PH_QKV_B, 0, 0, c); tab_add(t, PH_DIL, 0, 0, c); tab_add(t, PH_MERGE, 0, 0, c); }
            tab_add(t, PH_WO, layer, 1, 0);
        } else {
            tab_add(t, PH_MOD, layer, 0, -1); tab_add(t, PH_QKV_C, 0, 0, 0); tab_add(t, PH_QKNORM, 0, 0, 0); tab_add(t, PH_ATTN_C, 0, 0, 0); tab_add(t, PH_WO, layer, 2, 0);
        }
        tab_add(t, PH_MOD, layer, 1, -1);
        for (int s = 0; s < 4; ++s) tab_add(t, PH_MLP, layer, s, 0);
    }
    tab_add(t, PH_FINAL, 0, 0, 0);
    return t;
}
constexpr PhTab H_TAB = make_tab();
__constant__ PhTab g_tab = make_tab();
__constant__ float g_inv[32] = {1.000000000e+00f, 7.498942018e-01f, 5.623413324e-01f, 4.216965139e-01f, 3.162277639e-01f, 2.371373773e-01f, 1.778279394e-01f, 1.333521456e-01f, 1.000000015e-01f, 7.498942316e-02f, 5.623413250e-02f, 4.216964915e-02f, 3.162277490e-02f, 2.371373773e-02f, 1.778279431e-02f, 1.333521400e-02f, 9.999999776e-03f, 7.498942316e-03f, 5.623413250e-03f, 4.216964822e-03f, 3.162277630e-03f, 2.371373819e-03f, 1.778279431e-03f, 1.333521446e-03f, 1.000000047e-03f, 7.498941850e-04f, 5.623413017e-04f, 4.216965172e-04f, 3.162277571e-04f, 2.371373703e-04f, 1.778279402e-04f, 1.333521504e-04f};

typedef const __attribute__((address_space(4))) Params* PP;
__device__ __forceinline__ PP params_() { PP kp = (PP)__builtin_amdgcn_kernarg_segment_ptr(); asm volatile("" : "+s"(kp)); return kp; }
__device__ __forceinline__ int tid_() { int t = (int)threadIdx.x; asm volatile("" : "+v"(t)); return t; }
__device__ __forceinline__ int bid_() { int b = (int)blockIdx.x; asm volatile("" : "+s"(b)); return b; }
__device__ __forceinline__ unsigned cvt_pk_bf16(float lo, float hi) { unsigned r; asm volatile("v_cvt_pk_bf16_f32 %0, %1, %2" : "=v"(r) : "v"(lo), "v"(hi)); return r; }
__device__ __forceinline__ float bf_lo(unsigned w) { return __uint_as_float(w << 16); }
__device__ __forceinline__ float bf_hi(unsigned w) { return __uint_as_float(w & 0xffff0000u); }
__device__ __forceinline__ float wave_sum(float v) {
    v += __shfl_xor(v, 32); v += __shfl_xor(v, 16); v += __shfl_xor(v, 8); v += __shfl_xor(v, 4); v += __shfl_xor(v, 2); v += __shfl_xor(v, 1); return v;
}
__device__ __forceinline__ int seq_of_row(int m) { return m < TP ? (m >> 12) : 4 + ((m - TP) >> 14); }
__device__ __forceinline__ const float* mod_vec(PP p, int s, int layer, int which) {
    return (const float*)(p->ws + WS_MOD) + ((size_t)(s * 4 + layer) * 6 + which) * DM;
}

namespace pg8 {
constexpr int BM = 256, BK = 64, HALF = 128, HTB = HALF * BK * 2, STAGE_BYTES = 8 * HTB, NXCD = 8, WGM = 8;
__host__ __device__ __forceinline__ int lds_byte(int r, int c) { const int st = (r >> 4) * 2 + (c >> 5), rr = r & 15, cc = c & 31, ob = rr * 64 + cc * 2; return st * 1024 + (ob ^ (((ob >> 9) & 1) << 5)); }
__host__ __device__ __forceinline__ void stage_rc(int b, int& R, int& C) { const int st = b / 1024, sb = b % 1024, swz = sb ^ (((sb >> 9) & 1) << 5); R = (st >> 1) * 16 + swz / 64; C = (st & 1) * 32 + (swz % 64) / 2; }
__host__ __device__ __forceinline__ int perm32(int rho) { const int n = rho >> 4, i = rho & 15; return 8 * (i >> 2) + 4 * n + (i & 3); }

struct Unit { int pm, pn; };
struct Gemm { const bf16_t* A; const bf16_t* Bt; int lda, ldb, M, N, K;
              int pA_L, pA_d, pA_S, pB_L, pB_d, pB_S; };
__device__ __forceinline__ const char* tile_base(const bf16_t* base, int t, size_t tstep, int pL, int pd, int pS) {
    if (pL < 0) return (const char*)base + (size_t)t * tstep;
    const int p0 = t << 8, line = p0 >> pL, u0 = p0 & ((1 << pL) - 1), sb = line >> pd, rho = line & ((1 << pd) - 1);
    return (const char*)base + (size_t)((sb << pS) + rho + (u0 << pd)) * 2048;
}
struct StaticOrder {
    int nM, nN, nwg, G, c;
    __device__ void init(int M, int N, int G_, int c_) { nM = M / BM; nN = N / BM; nwg = nM * nN; G = G_; c = c_; }
    __device__ bool next(int i, Unit& u) const {
        const long L = (long)i * G + c; if (L >= nwg) return false;
        int wgid = (int)L; { const int q = nwg / NXCD, r = nwg % NXCD, xcd = wgid % NXCD, off = wgid / NXCD; wgid = (xcd < r ? xcd * (q + 1) : r * (q + 1) + (xcd - r) * q) + off; }
        const int nig = WGM * nN, gid = wgid / nig, fm = gid * WGM, gsz = (nM - fm) < WGM ? (nM - fm) : WGM;
        u.pm = fm + ((wgid % nig) % gsz); u.pn = (wgid % nig) / gsz; return true;
    }
};

struct Epi {
    int dry;
    int mode;
    bf16_t* O; int ldc;
    int log2L, log2d;
    const float* rope;
    const float* base_p; const float* base_s; const bf16_t* baseb; bf16_t* outb; const float* gate; int row_off;
    __device__ __forceinline__ void operator()(const f32x4 (&acc)[2][2][4][2], const Unit& u, int wr, int wc, int fr, int fq) const {
        const int row0 = u.pm * BM + wr * 64 + fr, col0 = u.pn * BM + wc * 32 + 8 * fq;
        if (dry) return;
        if (mode == 3) {
            const int g0 = row_off + u.pm * BM; const int s = seq_of_row(g0);
            const float* gv = gate + (size_t)s * (4 * 6 * DM) + col0;
            f32x4 gt[2][2];
#pragma unroll
            for (int bj = 0; bj < 2; ++bj)
#pragma unroll
                for (int n = 0; n < 2; ++n) gt[bj][n] = *(const f32x4*)(gv + bj * HALF + 4 * n);
            if (base_p) {
#pragma unroll
                for (int ai = 0; ai < 2; ++ai)
#pragma unroll
                    for (int m = 0; m < 4; ++m) {
                        const int gr = row_off + row0 + ai * HALF + m * 16;
                        bf16_t* op = outb + (size_t)gr * DM;
#pragma unroll
                        for (int bj = 0; bj < 2; ++bj) {
                            const int c = col0 + bj * HALF;
                            const float* bp = (gr < TP ? base_p + (size_t)gr * DM : base_s + (size_t)(gr - TP) * DM) + c;
                            const f32x4 b0 = *(const f32x4*)bp, b1 = *(const f32x4*)(bp + 4);
                            const f32x4 v0 = b0 + gt[bj][0] * acc[ai][bj][m][0], v1 = b1 + gt[bj][1] * acc[ai][bj][m][1];
                            u32x4 w; w.x = cvt_pk_bf16(v0[0], v0[1]); w.y = cvt_pk_bf16(v0[2], v0[3]); w.z = cvt_pk_bf16(v1[0], v1[1]); w.w = cvt_pk_bf16(v1[2], v1[3]);
                            *(u32x4*)(op + c) = w;
                        }
                    }
            } else {
#pragma unroll
                for (int ai = 0; ai < 2; ++ai) {
                    u32x4 bb[4][2];
#pragma unroll
                    for (int m = 0; m < 4; ++m) { const bf16_t* bp = baseb + (size_t)(row_off + row0 + ai * HALF + m * 16) * DM + col0;
#pragma unroll
                        for (int bj = 0; bj < 2; ++bj) bb[m][bj] = *(const u32x4*)(bp + bj * HALF); }
                    __builtin_amdgcn_sched_barrier(0);
#pragma unroll
                    for (int m = 0; m < 4; ++m) { bf16_t* op = outb + (size_t)(row_off + row0 + ai * HALF + m * 16) * DM + col0;
#pragma unroll
                        for (int bj = 0; bj < 2; ++bj) { const u32x4 ub = bb[m][bj];
                            const f32x4 b0 = {bf_lo(ub.x), bf_hi(ub.x), bf_lo(ub.y), bf_hi(ub.y)}, b1 = {bf_lo(ub.z), bf_hi(ub.z), bf_lo(ub.w), bf_hi(ub.w)};
                            const f32x4 v0 = b0 + gt[bj][0] * acc[ai][bj][m][0], v1 = b1 + gt[bj][1] * acc[ai][bj][m][1];
                            u32x4 w; w.x = cvt_pk_bf16(v0[0], v0[1]); w.y = cvt_pk_bf16(v0[2], v0[3]); w.z = cvt_pk_bf16(v1[0], v1[1]); w.w = cvt_pk_bf16(v1[2], v1[3]);
                            *(u32x4*)(op + bj * HALF) = w; } }
                    __builtin_amdgcn_sched_barrier(0);
                }
            }
            return;
        }
#pragma unroll
        for (int ai = 0; ai < 2; ++ai)
#pragma unroll
            for (int m = 0; m < 4; ++m) {
                const int row = row0 + ai * HALF + m * 16;
                bf16_t* rowp = O + (size_t)row * ldc + col0;
                f32x4 cs0 = {1.f, 0.f, 1.f, 0.f}, cs1 = {1.f, 0.f, 1.f, 0.f};
                if (mode == 1) {
                    const int L1 = (1 << log2L) - 1, line = row >> log2L, uu = row & L1, rho = line & ((1 << log2d) - 1), pos = (uu << log2d) + rho;
                    const float* tp = rope + ((size_t)pos * 32 + (wc & 1) * 16 + 4 * fq) * 2;
                    cs0 = *(const f32x4*)tp; cs1 = *(const f32x4*)(tp + 4);
                }
#pragma unroll
                for (int bj = 0; bj < 2; ++bj) {
                    f32x4 v0 = acc[ai][bj][m][0], v1 = acc[ai][bj][m][1];
                    if (mode == 2) {
#pragma unroll
                        for (int e = 0; e < 4; ++e) { float a = fmaxf(v0[e], 0.f), b = fmaxf(v1[e], 0.f); v0[e] = a * a; v1[e] = b * b; }
                    } else if (mode == 1) {
                        f32x4 r0, r1;
                        r0[0] = v0[0] * cs0[0] - v0[1] * cs0[1]; r0[1] = v0[0] * cs0[1] + v0[1] * cs0[0];
                        r0[2] = v0[2] * cs0[2] - v0[3] * cs0[3]; r0[3] = v0[2] * cs0[3] + v0[3] * cs0[2];
                        r1[0] = v1[0] * cs1[0] - v1[1] * cs1[1]; r1[1] = v1[0] * cs1[1] + v1[1] * cs1[0];
                        r1[2] = v1[2] * cs1[2] - v1[3] * cs1[3]; r1[3] = v1[2] * cs1[3] + v1[3] * cs1[2];
                        v0 = r0; v1 = r1;
                    }
                    u32x4 w; w.x = cvt_pk_bf16(v0[0], v0[1]); w.y = cvt_pk_bf16(v0[2], v0[3]); w.z = cvt_pk_bf16(v1[0], v1[1]); w.w = cvt_pk_bf16(v1[2], v1[3]);
                    *(u32x4*)(rowp + bj * HALF) = w;
                }
            }
    }
};

__device__ __forceinline__ void gemm_phase(LAS unsigned char* lds, const Gemm g, const StaticOrder& S, const Epi& E) {
    const int tid = tid_(), wid = __builtin_amdgcn_readfirstlane(tid >> 6), lane = tid & 63, wr = wid >> 2, wc = wid & 3, fr = lane & 15, fq = lane >> 4;
    const int K = g.K, nt = K / BK;
    unsigned voffA[2], voffB[2];
#pragma unroll
    for (int i = 0; i < 2; ++i) { int R, C; stage_rc(tid * 16 + i * 8192, R, C); const int Rb = (R & ~31) + perm32(R & 31);
        voffA[i] = (unsigned)(R * g.lda + C) * 2u; voffB[i] = (unsigned)(Rb * g.ldb + C) * 2u; }
    const size_t kstep = (size_t)(BK * 2);
    const size_t hstepA = (size_t)HALF * g.lda * 2, hstepB = (size_t)HALF * g.ldb * 2;
    const size_t tstepA = 2 * hstepA, tstepB = 2 * hstepB;
    const unsigned ldsw = (unsigned)wid * 1024u;
    const int aoff = lds_byte(wr * 64 + fr, fq * 8), boff = lds_byte(wc * 32 + fr, fq * 8);
#define PG8_SA(b, h) (((b) * 2 + (h)) * HTB)
#define PG8_SB(b, h) ((4 + (b) * 2 + (h)) * HTB)
#define PG8_STAGE(bufoff, gbase, voff) do { _Pragma("unroll") for (int _i = 0; _i < 2; ++_i) \
        __builtin_amdgcn_global_load_lds((const unsigned*)((const char*)(gbase) + (voff)[_i]), (LAS unsigned*)(lds + (bufoff) + ldsw + _i * 8192), 16, 0, 0); } while (0)
#define PG8_LDA(dst, b, h) do { _Pragma("unroll") for (int m = 0; m < 4; ++m) _Pragma("unroll") for (int k = 0; k < 2; ++k) dst[m][k] = *(const LAS bf16x8*)(lds + PG8_SA(b, h) + aoff + m * 2048 + k * 1024); } while (0)
#define PG8_LDB(dst, b, h) do { _Pragma("unroll") for (int n = 0; n < 2; ++n) _Pragma("unroll") for (int k = 0; k < 2; ++k) dst[n][k] = *(const LAS bf16x8*)(lds + PG8_SB(b, h) + boff + n * 2048 + k * 1024); } while (0)
#define PG8_MMA(ai, bj, At, Bt) do { __builtin_amdgcn_s_setprio(1); _Pragma("unroll") for (int m = 0; m < 4; ++m) _Pragma("unroll") for (int n = 0; n < 2; ++n) _Pragma("unroll") for (int k = 0; k < 2; ++k) \
        acc[ai][bj][m][n] = __builtin_amdgcn_mfma_f32_16x16x32_bf16(Bt[n][k], At[m][k], acc[ai][bj][m][n], 0, 0, 0); __builtin_amdgcn_s_setprio(0); } while (0)
#define PG8_WAIT_V(n) asm volatile("s_waitcnt vmcnt(" #n ")" ::: "memory")
#define PG8_WAIT_L(n) asm volatile("s_waitcnt lgkmcnt(" #n ")" ::: "memory")
#define PG8_BAR __builtin_amdgcn_s_barrier()
#define PG8_SCHED __builtin_amdgcn_sched_barrier(0)
    Unit cur, nxt; int ui = 0;
    if (!S.next(0, cur)) return;
    f32x4 acc[2][2][4][2];
#pragma unroll
    for (int a = 0; a < 2; ++a)
#pragma unroll
        for (int b = 0; b < 2; ++b)
#pragma unroll
            for (int m = 0; m < 4; ++m)
#pragma unroll
                for (int n = 0; n < 2; ++n) acc[a][b][m][n] = (f32x4){0.f, 0.f, 0.f, 0.f};
    bf16x8 At[4][2], B0[2][2], B1[2][2];
    const char* cA = tile_base(g.A, cur.pm, tstepA, g.pA_L, g.pA_d, g.pA_S); const char* cB = tile_base(g.Bt, cur.pn, tstepB, g.pB_L, g.pB_d, g.pB_S);
    PG8_STAGE(PG8_SB(0, 0), cB, voffB); PG8_STAGE(PG8_SB(0, 1), cB + hstepB, voffB); PG8_STAGE(PG8_SA(0, 0), cA, voffA); PG8_STAGE(PG8_SA(0, 1), cA + hstepA, voffA);
    if (wr == 1) PG8_BAR;
    PG8_WAIT_V(2); PG8_BAR;
    PG8_STAGE(PG8_SB(1, 0), cB + kstep, voffB); PG8_STAGE(PG8_SA(1, 0), cA + kstep, voffA); PG8_STAGE(PG8_SB(1, 1), cB + hstepB + kstep, voffB);
    PG8_WAIT_V(6); PG8_BAR;
    for (;;) {
        const bool has_next = S.next(ui + 1, nxt);
        const char* nA = has_next ? tile_base(g.A, nxt.pm, tstepA, g.pA_L, g.pA_d, g.pA_S) : cA; const char* nB = has_next ? tile_base(g.Bt, nxt.pn, tstepB, g.pB_L, g.pB_d, g.pB_S) : cB;
        for (int t = 0; t < nt; t += 2) {
            const bool last = (t == nt - 2);
            const char* a1 = cA + (size_t)(t + 1) * kstep;
            const char* a2 = last ? nA : cA + (size_t)(t + 2) * kstep; const char* b2 = last ? nB : cB + (size_t)(t + 2) * kstep;
            const char* a3 = a2 + kstep; const char* b3 = b2 + kstep;
            PG8_LDB(B0, 0, 0); PG8_LDB(B1, 0, 1); PG8_SCHED; PG8_LDA(At, 0, 0); PG8_STAGE(PG8_SA(1, 1), a1 + hstepA, voffA);
            PG8_WAIT_V(8); PG8_WAIT_L(0); PG8_BAR; PG8_MMA(0, 0, At, B0); PG8_MMA(0, 1, At, B1); PG8_BAR; PG8_SCHED;
            PG8_LDA(At, 0, 1); PG8_STAGE(PG8_SB(0, 0), b2, voffB); PG8_STAGE(PG8_SB(0, 1), b2 + hstepB, voffB); PG8_STAGE(PG8_SA(0, 0), a2, voffA);
            PG8_WAIT_V(8); PG8_WAIT_L(0); PG8_BAR; PG8_MMA(1, 0, At, B0); PG8_MMA(1, 1, At, B1); PG8_BAR; PG8_SCHED;
            PG8_LDB(B0, 1, 0); PG8_LDB(B1, 1, 1); PG8_SCHED; PG8_LDA(At, 1, 0); PG8_STAGE(PG8_SA(0, 1), a2 + hstepA, voffA);
            PG8_WAIT_V(8); PG8_WAIT_L(0); PG8_BAR; PG8_MMA(0, 0, At, B0); PG8_MMA(0, 1, At, B1); PG8_BAR; PG8_SCHED;
            PG8_LDA(At, 1, 1); PG8_STAGE(PG8_SB(1, 0), b3, voffB); PG8_STAGE(PG8_SB(1, 1), b3 + hstepB, voffB); PG8_STAGE(PG8_SA(1, 0), a3, voffA);
            PG8_WAIT_V(8); PG8_WAIT_L(0); PG8_BAR; PG8_MMA(1, 0, At, B0); PG8_MMA(1, 1, At, B1); PG8_BAR; PG8_SCHED;
        }
        if (wr == 0) PG8_BAR;
        E(acc, cur, wr, wc, fr, fq);
        if (!has_next) break;
#pragma unroll
        for (int a = 0; a < 2; ++a)
#pragma unroll
            for (int b = 0; b < 2; ++b)
#pragma unroll
                for (int m = 0; m < 4; ++m)
#pragma unroll
                    for (int n = 0; n < 2; ++n) acc[a][b][m][n] = (f32x4){0.f, 0.f, 0.f, 0.f};
        cur = nxt; cA = nA; cB = nB; ++ui;
        if (wr == 1) PG8_BAR;
    }
    if (E.dry) PG8_WAIT_V(0); else PG8_WAIT_V(16);
    PG8_BAR;
#undef PG8_SA
#undef PG8_SB
#undef PG8_STAGE
#undef PG8_LDA
#undef PG8_LDB
#undef PG8_MMA
#undef PG8_WAIT_V
#undef PG8_WAIT_L
#undef PG8_BAR
#undef PG8_SCHED
}
}

namespace att {
constexpr int D = 128, NW = 8, QBLK = 32, KVBLK = 64;
constexpr float SCALE = 0.088388347648318440f;
constexpr float THR = 8.f;
constexpr int LDQ = 1536, LDK = 1536, LDO = 1024;
constexpr size_t SHM_V = KVBLK * D * 2, SHM_K = KVBLK * D * 2, SHM_ATTN = 3 * SHM_V + 3 * SHM_K + NW * 64 * 4;
#define KSWZ(row, colB) ((row) * 256 + ((colB) ^ (((row) & 7) << 4)))
#define SBAR() __builtin_amdgcn_sched_barrier(0)
__device__ __forceinline__ int crow(int r, int hi) { return (r & 3) + 8 * (r >> 2) + 4 * hi; }
__device__ __forceinline__ void partialSM(f32x16& p0, f32x16& p1, float& m_reg, float& mn, float& alpha) {
    constexpr float C = SCALE * 1.4426950408889634f;
    float pmax = p0[0];
#pragma unroll
    for (int r = 1; r < 16; ++r) pmax = fmaxf(pmax, p0[r]);
#pragma unroll
    for (int r = 0; r < 16; ++r) pmax = fmaxf(pmax, p1[r]);
    { auto rr = __builtin_amdgcn_permlane32_swap(__float_as_uint(pmax), __float_as_uint(pmax), false, false);
      pmax = fmaxf(__uint_as_float(rr[0]), __uint_as_float(rr[1])); }
    if (__builtin_expect(__all(pmax - m_reg <= THR / SCALE), 1)) { mn = m_reg; alpha = 1.f; }
    else { mn = fmaxf(m_reg, pmax); alpha = __builtin_amdgcn_exp2f((m_reg - mn) * C); m_reg = mn; }
    float mnC = -mn * C;
#pragma unroll
    for (int r = 0; r < 16; ++r) p0[r] = fmaf(p0[r], C, mnC);
#pragma unroll
    for (int r = 0; r < 16; ++r) p1[r] = fmaf(p1[r], C, mnC);
#pragma unroll
    for (int r = 0; r < 16; ++r) p0[r] = __builtin_amdgcn_exp2f(p0[r]);
}
__device__ __forceinline__ void finishSM(f32x16& p0, f32x16& p1, float alpha, float& l_reg, bf16x8& pa0, bf16x8& pa1, bf16x8& pa2, bf16x8& pa3) {
#pragma unroll
    for (int r = 0; r < 16; ++r) p1[r] = __builtin_amdgcn_exp2f(p1[r]);
    float ps = 0;
#pragma unroll
    for (int r = 0; r < 16; ++r) ps += p0[r];
#pragma unroll
    for (int r = 0; r < 16; ++r) ps += p1[r];
    { auto rr = __builtin_amdgcn_permlane32_swap(__float_as_uint(ps), __float_as_uint(ps), false, false);
      ps = __uint_as_float(rr[0]) + __uint_as_float(rr[1]); }
    l_reg = l_reg * alpha + ps;
#define PK4(P, BASE, OUT) do { unsigned a0 = cvt_pk_bf16(P[BASE + 0], P[BASE + 1]), a1 = cvt_pk_bf16(P[BASE + 2], P[BASE + 3]);   \
    unsigned b0 = cvt_pk_bf16(P[BASE + 4], P[BASE + 5]), b1 = cvt_pk_bf16(P[BASE + 6], P[BASE + 7]);                              \
    auto r0 = __builtin_amdgcn_permlane32_swap(a0, b0, false, false); auto r1 = __builtin_amdgcn_permlane32_swap(a1, b1, false, false); \
    u32x4 w = {r0[0], r1[0], r0[1], r1[1]}; OUT = *reinterpret_cast<bf16x8*>(&w); } while (0)
    PK4(p0, 0, pa0); PK4(p0, 8, pa1); PK4(p1, 0, pa2); PK4(p1, 8, pa3);
#undef PK4
}
__device__ __forceinline__ void qkt(f32x16& p0, f32x16& p1, const bf16_t* Ks, const bf16x8* qr, int r32, int hi) {
    p0 = f32x16{}; p1 = f32x16{};
#pragma unroll
    for (int d0 = 0; d0 < 8; ++d0) { int cb = (d0 * 16 + hi * 8) * 2;
        bf16x8 b0 = *reinterpret_cast<const bf16x8*>((const char*)Ks + KSWZ(r32, cb));
        bf16x8 b1 = *reinterpret_cast<const bf16x8*>((const char*)Ks + KSWZ(32 + r32, cb));
        p0 = __builtin_amdgcn_mfma_f32_32x32x16_bf16(b0, qr[d0], p0, 0, 0, 0);
        p1 = __builtin_amdgcn_mfma_f32_32x32x16_bf16(b1, qr[d0], p1, 0, 0, 0); }
}
__device__ __forceinline__ int v_st(int k, int c) { const int kk = (k & ~0xC) | ((k & 4) << 1) | ((k & 8) >> 1); return ((kk >> 3) * 4 + (c >> 5)) * 512 + ((kk & 7) * 32 + (c & 31)) * 2; }
__device__ __forceinline__ int v_rd_base(int lane) { return ((lane & 3) << 3) | (((lane >> 2) & 3) << 6) | (((lane >> 4) & 1) << 5) | (((lane >> 5) & 1) << 8); }
constexpr int v_rd_off(int d0, int ks, int half) { return d0 * 512 + ks * 4096 + half * 2048; }
template <int OFF> __device__ __forceinline__ s16x4 tr_read(int vb) {
    s16x4 r; asm volatile("ds_read_b64_tr_b16 %0, %1 offset:%2" : "=&v"(r) : "v"(vb), "i"(OFF) : "memory"); return r;
}
template <int D0> __device__ __forceinline__ void pv_one(f32x16& od, int vb, bf16x8 pa0, bf16x8 pa1, bf16x8 pa2, bf16x8 pa3) {
    const s16x4 l0 = tr_read<v_rd_off(D0, 0, 0)>(vb), h0 = tr_read<v_rd_off(D0, 0, 1)>(vb), l1 = tr_read<v_rd_off(D0, 1, 0)>(vb), h1 = tr_read<v_rd_off(D0, 1, 1)>(vb);
    const s16x4 l2 = tr_read<v_rd_off(D0, 2, 0)>(vb), h2 = tr_read<v_rd_off(D0, 2, 1)>(vb), l3 = tr_read<v_rd_off(D0, 3, 0)>(vb), h3 = tr_read<v_rd_off(D0, 3, 1)>(vb);
    asm volatile("s_waitcnt lgkmcnt(0)" ::: "memory"); SBAR();
#define PK(L, H) (bf16x8){L[0], L[1], L[2], L[3], H[0], H[1], H[2], H[3]}
    od = __builtin_amdgcn_mfma_f32_32x32x16_bf16(pa0, PK(l0, h0), od, 0, 0, 0);
    od = __builtin_amdgcn_mfma_f32_32x32x16_bf16(pa1, PK(l1, h1), od, 0, 0, 0);
    od = __builtin_amdgcn_mfma_f32_32x32x16_bf16(pa2, PK(l2, h2), od, 0, 0, 0);
    od = __builtin_amdgcn_mfma_f32_32x32x16_bf16(pa3, PK(l3, h3), od, 0, 0, 0);
#undef PK
}
__device__ __forceinline__ void pv_d0(f32x16* o, int vb, bf16x8 pa0, bf16x8 pa1, bf16x8 pa2, bf16x8 pa3) {
    pv_one<0>(o[0], vb, pa0, pa1, pa2, pa3); pv_one<1>(o[1], vb, pa0, pa1, pa2, pa3); pv_one<2>(o[2], vb, pa0, pa1, pa2, pa3); pv_one<3>(o[3], vb, pa0, pa1, pa2, pa3);
}
__device__ __forceinline__ void attn_dense_body(const bf16_t* __restrict__ Qb, const bf16_t* __restrict__ Kh, const bf16_t* __restrict__ Vh,
                                                bf16_t* __restrict__ Ob, int seq, char* lds, int dry) {
    const int tid = tid_(), wid = tid >> 6, lane = tid & 63, r32 = lane & 31, hi = lane >> 5;
    bf16_t* V_lds = (bf16_t*)lds; bf16_t* K_lds = (bf16_t*)(lds + 3 * SHM_V);
    float* ws = (float*)(lds + 3 * SHM_V + 3 * SHM_K) + wid * 64; float* li_l = ws; float* al_l = ws + 32;
    float m_reg = -1e30f, l_reg = 0; f32x16 o[4] = {}; bf16x8 qr[8];
    const bf16_t* Qw = Qb + (long)(wid * QBLK + r32) * LDQ + hi * 8;
#pragma unroll
    for (int d0 = 0; d0 < 8; ++d0) qr[d0] = *reinterpret_cast<const bf16x8*>(Qw + d0 * 16);
    const int sr = tid >> 4, sc = (tid & 15) * 8, vst0 = v_st(sr, sc), vst1 = v_st(32 + sr, sc);
    const int vb0 = (int)(uintptr_t)V_lds + v_rd_base(lane);
    bf16x8 sv0[2], sv1[2], sk0[2], sk1[2];
#define SLOAD(i, k0) do { sv0[i] = *(const bf16x8*)(&Vh[(long)((k0) + sr) * LDK + sc]); sv1[i] = *(const bf16x8*)(&Vh[(long)((k0) + 32 + sr) * LDK + sc]); \
    sk0[i] = *(const bf16x8*)(&Kh[(long)((k0) + sr) * LDK + sc]); sk1[i] = *(const bf16x8*)(&Kh[(long)((k0) + 32 + sr) * LDK + sc]); } while (0)
#define SWRITE(off, i) do { *(bf16x8*)((char*)V_lds + (off) + vst0) = sv0[i];          \
    *(bf16x8*)((char*)V_lds + (off) + vst1) = sv1[i]; int kc = sc * 2;               \
    *(bf16x8*)((char*)K_lds + (off) + KSWZ(sr, kc)) = sk0[i];                       \
    *(bf16x8*)((char*)K_lds + (off) + KSWZ(32 + sr, kc)) = sk1[i]; } while (0)
#define SWAIT() asm volatile("s_waitcnt vmcnt(4)" ::: "memory")
#define RESC(a) do { if (__any((a) < 1.f)) { if (hi == 0) al_l[r32] = (a); asm volatile("s_waitcnt lgkmcnt(0)" ::: "memory"); \
    _Pragma("unroll") for (int d = 0; d < 4; ++d) _Pragma("unroll") for (int r = 0; r < 16; ++r) o[d][r] *= al_l[crow(r, hi)]; } } while (0)
    f32x16 pA0, pA1, pB0, pB1; float mnA, mnB, alA, alB; bf16x8 pa0, pa1, pa2, pa3; const int NT = seq / KVBLK;
    SLOAD(0, 0); asm volatile("s_waitcnt vmcnt(0)" ::: "memory"); SWRITE(0, 0); __syncthreads();
    qkt(pA0, pA1, K_lds, qr, r32, hi); partialSM(pA0, pA1, m_reg, mnA, alA);
    SLOAD(1, KVBLK); if (2 < NT) SLOAD(0, 2 * KVBLK);
    SWAIT(); SWRITE((int)SHM_K, 1); __syncthreads();
    int oq = (int)SHM_K, ov = 0, ow = 2 * (int)SHM_K;
    for (int j = 1; j + 1 < NT; j += 2) {
        SBAR(); qkt(pB0, pB1, (bf16_t*)((char*)K_lds + oq), qr, r32, hi);
        finishSM(pA0, pA1, alA, l_reg, pa0, pa1, pa2, pa3); SBAR();
        SLOAD(1, (j + 2) * KVBLK); SBAR();
        pv_d0(o, vb0 + ov, pa0, pa1, pa2, pa3); partialSM(pB0, pB1, m_reg, mnB, alB);
        SWAIT(); SWRITE(ow, 0);
        RESC(alB); __syncthreads();
        { const int t_ = ov; ov = oq; oq = ow; ow = t_; }
        SBAR(); qkt(pA0, pA1, (bf16_t*)((char*)K_lds + oq), qr, r32, hi);
        finishSM(pB0, pB1, alB, l_reg, pa0, pa1, pa2, pa3); SBAR();
        if (j + 3 < NT) SLOAD(0, (j + 3) * KVBLK); SBAR();
        pv_d0(o, vb0 + ov, pa0, pa1, pa2, pa3); partialSM(pA0, pA1, m_reg, mnA, alA);
        SWAIT(); SWRITE(ow, 1);
        RESC(alA); __syncthreads();
        { const int t_ = ov; ov = oq; oq = ow; ow = t_; }
    }
    SBAR(); qkt(pB0, pB1, (bf16_t*)((char*)K_lds + oq), qr, r32, hi);
    finishSM(pA0, pA1, alA, l_reg, pa0, pa1, pa2, pa3); SBAR();
    pv_d0(o, vb0 + ov, pa0, pa1, pa2, pa3); partialSM(pB0, pB1, m_reg, mnB, alB);
    RESC(alB);
    finishSM(pB0, pB1, alB, l_reg, pa0, pa1, pa2, pa3); SBAR();
    pv_d0(o, vb0 + oq, pa0, pa1, pa2, pa3);
    if (hi == 0) li_l[r32] = l_reg; asm volatile("s_waitcnt lgkmcnt(0)" ::: "memory");
    float rli[16];
#pragma unroll
    for (int r = 0; r < 16; ++r) rli[r] = __builtin_amdgcn_rcpf(li_l[crow(r, hi)]);
    bf16_t* Ow = Ob + (long)(wid * QBLK) * LDO;
    if (!dry)
#pragma unroll
    for (int r = 0; r < 16; ++r) { int orow = crow(r, hi);
#pragma unroll
        for (int d0 = 0; d0 < 4; ++d0) Ow[(long)orow * LDO + d0 * 32 + r32] = (bf16_t)(cvt_pk_bf16(o[d0][r] * rli[r], 0.f) & 0xffffu); }
#undef SLOAD
#undef SWRITE
#undef SWAIT
#undef RESC
}
}

__device__ __forceinline__ void conv_matrix(const float* __restrict__ src, bf16_t* __restrict__ dst, int K, int N, int permmode, float* tile) {
    const int tid = tid_(); const int ntn = N >> 6, ntk = K >> 8, ntiles = ntn * ntk;
    for (int tl = bid_(); tl < ntiles; tl += gridDim.x) {
        const int tk = tl / ntn, tn = tl - tk * ntn, k0 = tk << 8, n0 = tn << 6;
        f32x4 v[8];
#pragma unroll
        for (int i = 0; i < 8; ++i) v[i] = *(const f32x4*)(src + (size_t)(k0 + (tid >> 4) + 32 * i) * N + n0 + (tid & 15) * 4);
#pragma unroll
        for (int i = 0; i < 8; ++i) { float* tp = tile + ((tid >> 4) + 32 * i) * 68 + (tid & 15) * 4; tp[0] = v[i][0]; tp[1] = v[i][1]; tp[2] = v[i][2]; tp[3] = v[i][3]; }
        __syncthreads();
        {
            const int n = tid >> 3, kc = (tid & 7) * 32;
            const bool pm = (permmode & 1) && ((n0 % 3072) < 2048);
            const float qs = ((permmode & 2) && ((n0 % 3072) < 1024)) ? 0.125f * LOG2E : 1.f;
            const int ns = pm ? ((n >> 1) + 32 * (n & 1)) : n;
#pragma unroll
            for (int q = 0; q < 4; ++q) {
                float x[8];
#pragma unroll
                for (int e = 0; e < 8; ++e) x[e] = tile[(kc + q * 8 + e) * 68 + ns] * qs;
                u32x4 w; w.x = cvt_pk_bf16(x[0], x[1]); w.y = cvt_pk_bf16(x[2], x[3]); w.z = cvt_pk_bf16(x[4], x[5]); w.w = cvt_pk_bf16(x[6], x[7]);
                *(u32x4*)(dst + (size_t)(n0 + n) * K + k0 + kc + q * 8) = w;
            }
        }
        __syncthreads();
    }
}

__device__ __forceinline__ void phase_init(PP p, unsigned char* lds) {
    const int tid = tid_(), wid = tid >> 6, lane = tid & 63;
    float* sm = (float*)lds;
    {
        float* rt = (float*)(p->ws + WS_ROPE);
        for (int i = bid_() * NTHREADS + tid; i < 16384 * 32; i += gridDim.x * NTHREADS) {
            const int pos = i >> 5, f = i & 31;
            const float ang = (float)pos * g_inv[f];
            float s, c; sincosf(ang, &s, &c);
            rt[2 * i] = c; rt[2 * i + 1] = s;
        }
    }
    for (int i = tid; i < 6 * 1024; i += NTHREADS) {
        const int s = i >> 10, k = i & 1023;
        const float c = s < 4 ? p->c_prompt[s * 1024 + k] : p->c_sample[(s - 4) * 1024 + k];
        sm[i] = c / (1.f + __expf(-c));
    }
    __syncthreads();
    float* part = sm + 6144;
    for (int u = bid_(); u < 4 * 192; u += gridDim.x) {
        const int l = u / 192, j0 = (u % 192) * 32, c4 = (lane & 7) * 4, kq = lane >> 3;
        const float* wp = p->w_mod + (size_t)l * 1024 * 6144 + (size_t)(wid * 128 + kq) * 6144 + j0 + c4;
        f32x4 a[6];
#pragma unroll
        for (int s6 = 0; s6 < 6; ++s6) a[s6] = (f32x4){0.f, 0.f, 0.f, 0.f};
#pragma unroll 8
        for (int k = 0; k < 16; ++k) {
            const f32x4 w = *(const f32x4*)(wp + (size_t)(8 * k) * 6144); const int kk = wid * 128 + kq + 8 * k;
#pragma unroll
            for (int s6 = 0; s6 < 6; ++s6) a[s6] += w * sm[s6 * 1024 + kk];
        }
#pragma unroll
        for (int s6 = 0; s6 < 6; ++s6)
#pragma unroll
            for (int e = 0; e < 4; ++e) { float v = a[s6][e]; v += __shfl_xor(v, 8); v += __shfl_xor(v, 16); v += __shfl_xor(v, 32); a[s6][e] = v; }
        if (kq == 0) {
#pragma unroll
            for (int s6 = 0; s6 < 6; ++s6) *(f32x4*)(part + (wid * 6 + s6) * 32 + c4) = a[s6];
        }
        __syncthreads();
        if (tid < 192) {
            const int s6 = tid >> 5, col = tid & 31;
            float v = 0;
#pragma unroll
            for (int w = 0; w < 8; ++w) v += part[(w * 6 + s6) * 32 + col];
            ((float*)(p->ws + WS_MOD))[(size_t)(s6 * 4 + l) * 6144 + j0 + col] = v + p->b_mod[l * 6144 + j0 + col];
        }
        __syncthreads();
    }
    bf16_t* W = (bf16_t*)(p->ws + WS_W);
    float* tile = (float*)lds;
    __syncthreads();
    for (int j = 0; j < 2; ++j) conv_matrix(p->a_w_qkv + (size_t)j * 1024 * 3072, W + W_AQKV + (size_t)j * 3072 * 1024, 1024, 3072, 2, tile);
    for (int j = 0; j < 2; ++j) conv_matrix(p->a_w_o + (size_t)j * 1024 * 1024, W + W_AO + (size_t)j * 1024 * 1024, 1024, 1024, 0, tile);
    conv_matrix(p->b_w_qkv, W + W_BQKV, 1024, 9216, 3, tile);
    conv_matrix(p->b_w_o, W + W_BO, 1024, 1024, 0, tile);
    conv_matrix(p->c_w_qkv, W + W_CQKV, 1024, 1536, 0, tile);
    conv_matrix(p->c_w_o, W + W_CO, 1024, 1024, 0, tile);
    for (int l = 0; l < 4; ++l) conv_matrix(p->mlp_w1 + (size_t)l * 1024 * 4096, W + W_1 + (size_t)l * 4096 * 1024, 1024, 4096, 0, tile);
    for (int l = 0; l < 4; ++l) conv_matrix(p->mlp_w2 + (size_t)l * 4096 * 1024, W + W_2 + (size_t)l * 1024 * 4096, 4096, 1024, 0, tile);
}

__device__ __forceinline__ void phase_modulate(PP p, int layer, int which, int row0, int nrows, int mode) {
    const int tid = tid_(), wid = tid >> 6, lane = tid & 63;
    const int nw = gridDim.x * 8, wg = bid_() * 8 + wid;
    const int rpw = (nrows + nw - 1) / nw;
    int r_lo = wg * rpw, r_hi = r_lo + rpw; if (r_hi > nrows) r_hi = nrows;
    const bool from_input = (layer == 0 && which == 0);
    const float* ng = p->norm_g + (size_t)(layer * 2 + which) * DM;
    bf16_t* H = (bf16_t*)(p->ws + WS_H);
    int cur_s = -1; f32x4 gs[4], sh[4];
#pragma unroll
    for (int k = 0; k < 4; ++k) { gs[k] = (f32x4){0, 0, 0, 0}; sh[k] = (f32x4){0, 0, 0, 0}; }
    constexpr int NR = 3;
    for (int r = r_lo; r < r_hi; r += NR) {
        f32x4 x[NR][4];
#pragma unroll
        for (int q = 0; q < NR; ++q) {
            const int m = row0 + (r + q < r_hi ? r + q : r_hi - 1);
            if (from_input) {
                const float* xr = (m < TP ? p->x_prompt + (size_t)m * DM : p->x_sample + (size_t)(m - TP) * DM) + 8 * lane;
#pragma unroll
                for (int k = 0; k < 2; ++k) { x[q][2 * k] = *(const f32x4*)(xr + 512 * k); x[q][2 * k + 1] = *(const f32x4*)(xr + 512 * k + 4); }
            } else {
                const bf16_t* xr = (const bf16_t*)p->out + (size_t)m * DM + 8 * lane;
#pragma unroll
                for (int k = 0; k < 2; ++k) { const u32x4 ub = *(const u32x4*)(xr + 512 * k);
                    x[q][2 * k] = (f32x4){bf_lo(ub.x), bf_hi(ub.x), bf_lo(ub.y), bf_hi(ub.y)}; x[q][2 * k + 1] = (f32x4){bf_lo(ub.z), bf_hi(ub.z), bf_lo(ub.w), bf_hi(ub.w)}; }
            }
        }
#pragma unroll
        for (int q = 0; q < NR; ++q) {
            if (r + q < r_hi) {
                const int m = row0 + r + q; const int s = seq_of_row(m);
                if (s != cur_s) {
                    cur_s = s;
                    const float* shv = mod_vec(p, s, layer, which * 3 + 0); const float* scv = mod_vec(p, s, layer, which * 3 + 1);
#pragma unroll
                    for (int k = 0; k < 4; ++k) {
                        const int c = 8 * lane + 512 * (k >> 1) + 4 * (k & 1);
                        const f32x4 g = *(const f32x4*)(ng + c), sc = *(const f32x4*)(scv + c);
                        gs[k] = g * (sc + 1.f); sh[k] = *(const f32x4*)(shv + c);
                    }
                }
                float ss = 0;
#pragma unroll
                for (int k = 0; k < 4; ++k) ss += x[q][k][0] * x[q][k][0] + x[q][k][1] * x[q][k][1] + x[q][k][2] * x[q][k][2] + x[q][k][3] * x[q][k][3];
                ss = wave_sum(ss);
                const float rstd = rsqrtf(ss * (1.f / 1024.f) + EPS);
                bf16_t* hp = H + (size_t)m * DM + 8 * lane;
#pragma unroll
                for (int k = 0; k < 2; ++k) {
                    const f32x4 h0 = x[q][2 * k] * rstd * gs[2 * k] + sh[2 * k], h1 = x[q][2 * k + 1] * rstd * gs[2 * k + 1] + sh[2 * k + 1];
                    u32x4 w; w.x = cvt_pk_bf16(h0[0], h0[1]); w.y = cvt_pk_bf16(h0[2], h0[3]); w.z = cvt_pk_bf16(h1[0], h1[1]); w.w = cvt_pk_bf16(h1[2], h1[3]);
                    *(u32x4*)(hp + 512 * k) = w;
                }
            }
        }
    }
}

__device__ __forceinline__ void phase_final(PP p) {
    const int tid = tid_(), wid = tid >> 6, lane = tid & 63;
    const int nw = gridDim.x * 8, wg = bid_() * 8 + wid;
    f32x4 g[4];
#pragma unroll
    for (int k = 0; k < 4; ++k) g[k] = *(const f32x4*)(p->final_g + 4 * lane + 256 * k);
    for (int m = wg; m < T; m += nw) {
        const bf16_t* xr = (const bf16_t*)(p->ws + WS_H) + (size_t)m * DM;
        float* yr = p->out + (size_t)m * DM;
        f32x4 x[4]; float ss = 0;
#pragma unroll
        for (int k = 0; k < 4; ++k) { const u32x2 ub = *(const u32x2*)(xr + 4 * lane + 256 * k); x[k] = (f32x4){bf_lo(ub.x), bf_hi(ub.x), bf_lo(ub.y), bf_hi(ub.y)};
            ss += x[k][0] * x[k][0] + x[k][1] * x[k][1] + x[k][2] * x[k][2] + x[k][3] * x[k][3]; }
        ss = wave_sum(ss);
        const float rstd = rsqrtf(ss * (1.f / 1024.f) + EPS);
#pragma unroll
        for (int k = 0; k < 4; ++k) *(f32x4*)(yr + 4 * lane + 256 * k) = x[k] * rstd * g[k];
    }
}

constexpr int NAT_SLOT = 16384, NAT_TAB = 9 * NAT_SLOT, NAT_MRG = NAT_TAB + 1920, NAT_END = NAT_MRG + 4 * 2560;
__device__ __forceinline__ void phase_natten(PP p, int j, int dry, unsigned char* lds_g) {
    LAS unsigned char* lds = (LAS unsigned char*)lds_g;
    const int tid = tid_(), wid = __builtin_amdgcn_readfirstlane(tid >> 6), lane = tid & 63, fr = lane & 15, fq = lane >> 4;
    bf16_t* QK = (bf16_t*)(p->ws + WS_R);
    const bf16_t* VT = (const bf16_t*)(p->ws + WS_R + R_VT);
    const float* rpb = p->a_rpb + (size_t)j * 16 * 15 * 31;
    const int half = wid >> 2, jq = half ? ((wid & 3) ^ 1) : wid;
    const int krt = 8 * (fr >> 2) + (fr & 3);
    const int qc = 16 * jq + fr; int cs = qc - 8; cs = cs < 0 ? 0 : (cs > 48 ? 48 : cs);
    int cbase = 16 * jq - 8; cbase = cbase < 0 ? 0 : (cbase > 32 ? 32 : cbase);
    const int g8k = (cbase >> 3) + (fr >> 2), g8v = (cbase >> 3) + fq;
    const int laneK = (g8k >> 2) * 4096 + (fq * 16 + 4 * (g8k & 3) + (fr & 3)) * 16;
    const int laneV = 8192 + (g8v >> 2) * 4096 + ((g8v & 3) * 16 + fr) * 16;
    int dco[2][4];
#pragma unroll
    for (int tt = 0; tt < 2; ++tt)
#pragma unroll
        for (int e = 0; e < 4; ++e) { const int kc = cbase + 8 * fq + 4 * tt + e; const bool valid = (kc >= cs) && (kc < cs + 16); dco[tt][e] = (valid ? (kc - qc + 15) : 31) * 4; }
#define NAT_PIECE(kr_, f_) do { const int f2_ = (f_); LAS unsigned char* dst_ = lds + ((kr_) % 9) * NAT_SLOT + f2_ * 1024; \
        if (f2_ < 8) { const int col_ = 32 * (f2_ >> 2) + krt + 4 * ((f2_ >> 1) & 1); \
            __builtin_amdgcn_global_load_lds((const unsigned*)(QK + (size_t)(start + (kr_) * 64 + col_) * LDA_QK + 1024 + h * 64 + 32 * (f2_ & 1) + 8 * fq), (LAS unsigned*)dst_, 16, 0, 0); } \
        else { const int g2_ = f2_ - 8; \
            __builtin_amdgcn_global_load_lds((const unsigned*)(VT + (size_t)(h * 64 + 16 * (fr >> 2) + 4 * (g2_ & 3) + (fr & 3)) * LDA_VT + start + (kr_) * 64 + 32 * (g2_ >> 2) + 8 * fq), (LAS unsigned*)dst_, 16, 0, 0); } \
    } while (0)
    for (int bt = bid_(); bt < 768; bt += (int)gridDim.x) {
        const int band = bt >> 4, h = bt & 15;
        int start, rows, r0;
        if (band < 16) { start = (band >> 2) * 4096; rows = 64; r0 = (band & 3) * 16; }
        else { const int b2 = band - 16; start = TP + (b2 >> 4) * 16384; rows = 256; r0 = (b2 & 15) * 16; }
        if (tid < 480) { const int dc = tid & 31, dr = tid >> 5; *(LAS float*)(lds + NAT_TAB + tid * 4) = dc < 31 ? rpb[(h * 15 + dr) * 31 + dc] * LOG2E : -1e30f; }
        { int rs0 = r0 - 4; rs0 = rs0 < 0 ? 0 : (rs0 > rows - 8 ? rows - 8 : rs0);
#pragma unroll
          for (int f = 0; f < 16; ++f) NAT_PIECE(rs0 + wid, f); }
        bf16_t* qrow = QK + (size_t)(start + r0 * 64 + 16 * jq + fr) * LDA_QK + h * 64;
        bf16x8 q0 = *(const bf16x8*)(qrow + 8 * fq), q1 = *(const bf16x8*)(qrow + 8 * fq + 32);
        u32x4 pw0 = {0u, 0u, 0u, 0u}, pw1 = {0u, 0u, 0u, 0u};
#pragma unroll 1
        for (int r = r0; r < r0 + 16; ++r) {
            int rs = r - 4; rs = rs < 0 ? 0 : (rs > rows - 8 ? rows - 8 : rs);
            asm volatile("s_waitcnt vmcnt(0) lgkmcnt(0)" ::: "memory"); __builtin_amdgcn_s_barrier(); asm volatile("" ::: "memory");
            bf16x8 qn0 = q0, qn1 = q1;
            if (r + 1 < r0 + 16) { qn0 = *(const bf16x8*)(qrow + (size_t)64 * LDA_QK + 8 * fq); qn1 = *(const bf16x8*)(qrow + (size_t)64 * LDA_QK + 8 * fq + 32); }
            if (r + 1 < r0 + 16) { int rsn = r - 3; rsn = rsn < 0 ? 0 : (rsn > rows - 8 ? rows - 8 : rsn);
                if (rsn != rs) { NAT_PIECE(rs + 8, 2 * wid); NAT_PIECE(rs + 8, 2 * wid + 1); } }
            if (half == 0 && r > r0 && !dry) { bf16_t* op = qrow - (size_t)64 * LDA_QK + 16 * fq; *(u32x4*)op = pw0; *(u32x4*)(op + 8) = pw1; }
            f32x4 s[4][2];
            float mx = -1e30f;
#define NAT_LOADK(i_, KF, TV) do { const int kr_ = rs + 4 * half + (i_); \
                const LAS unsigned char* sb_ = lds + (kr_ % 9) * NAT_SLOT + laneK; const LAS unsigned char* tb_ = lds + NAT_TAB + (kr_ - r + 7) * 128; \
                _Pragma("unroll") for (int f = 0; f < 4; ++f) KF[f] = *(const LAS bf16x8*)(sb_ + f * 1024); \
                _Pragma("unroll") for (int tt = 0; tt < 2; ++tt) _Pragma("unroll") for (int e = 0; e < 4; ++e) TV[tt * 4 + e] = *(const LAS float*)(tb_ + dco[tt][e]); } while (0)
#define NAT_SCORE(i_, KF, TV) do { \
                _Pragma("unroll") for (int tt = 0; tt < 2; ++tt) { \
                    f32x4 a_ = {TV[tt * 4], TV[tt * 4 + 1], TV[tt * 4 + 2], TV[tt * 4 + 3]};        \
                    a_ = __builtin_amdgcn_mfma_f32_16x16x32_bf16(KF[tt * 2], q0, a_, 0, 0, 0); \
                    a_ = __builtin_amdgcn_mfma_f32_16x16x32_bf16(KF[tt * 2 + 1], q1, a_, 0, 0, 0); \
                    s[i_][tt] = a_; mx = fmaxf(mx, fmaxf(fmaxf(a_[0], a_[1]), fmaxf(a_[2], a_[3]))); } } while (0)
            {
                bf16x8 kfA[4], kfB[4]; float tvA[8], tvB[8];
                NAT_LOADK(0, kfA, tvA);
                NAT_LOADK(1, kfB, tvB); __builtin_amdgcn_sched_barrier(0);
                NAT_SCORE(0, kfA, tvA); __builtin_amdgcn_sched_barrier(0);
                NAT_LOADK(2, kfA, tvA); __builtin_amdgcn_sched_barrier(0);
                NAT_SCORE(1, kfB, tvB); __builtin_amdgcn_sched_barrier(0);
                NAT_LOADK(3, kfB, tvB); __builtin_amdgcn_sched_barrier(0);
                NAT_SCORE(2, kfA, tvA); __builtin_amdgcn_sched_barrier(0);
                NAT_SCORE(3, kfB, tvB);
            }
#undef NAT_LOADK
#undef NAT_SCORE
            mx = fmaxf(mx, __shfl_xor(mx, 16)); mx = fmaxf(mx, __shfl_xor(mx, 32));
            float l = 0;
            f32x4 o[4];
#pragma unroll
            for (int nt = 0; nt < 4; ++nt) o[nt] = (f32x4){0.f, 0.f, 0.f, 0.f};
#define NAT_LOADV(i_, VF) do { const int kr_ = rs + 4 * half + (i_); const LAS unsigned char* sb_ = lds + (kr_ % 9) * NAT_SLOT + laneV; \
                _Pragma("unroll") for (int f = 0; f < 4; ++f) VF[f] = *(const LAS bf16x8*)(sb_ + f * 1024); } while (0)
#define NAT_PV(i_, VF) do { float pv_[8]; \
                _Pragma("unroll") for (int tt = 0; tt < 2; ++tt) _Pragma("unroll") for (int e = 0; e < 4; ++e) { const float pe_ = __builtin_amdgcn_exp2f(s[i_][tt][e] - mx); pv_[4 * tt + e] = pe_; l += pe_; } \
                u32x4 w_; w_.x = cvt_pk_bf16(pv_[0], pv_[1]); w_.y = cvt_pk_bf16(pv_[2], pv_[3]); w_.z = cvt_pk_bf16(pv_[4], pv_[5]); w_.w = cvt_pk_bf16(pv_[6], pv_[7]); \
                const bf16x8 pa_ = *reinterpret_cast<bf16x8*>(&w_); \
                _Pragma("unroll") for (int nt = 0; nt < 4; ++nt) o[nt] = __builtin_amdgcn_mfma_f32_16x16x32_bf16(VF[nt], pa_, o[nt], 0, 0, 0); } while (0)
            {
                bf16x8 vfA[4], vfB[4];
                NAT_LOADV(0, vfA);
                NAT_LOADV(1, vfB); __builtin_amdgcn_sched_barrier(0);
                NAT_PV(0, vfA); __builtin_amdgcn_sched_barrier(0);
                NAT_LOADV(2, vfA); __builtin_amdgcn_sched_barrier(0);
                NAT_PV(1, vfB); __builtin_amdgcn_sched_barrier(0);
                NAT_LOADV(3, vfB); __builtin_amdgcn_sched_barrier(0);
                NAT_PV(2, vfA); __builtin_amdgcn_sched_barrier(0);
                NAT_PV(3, vfB);
            }
#undef NAT_LOADV
#undef NAT_PV
            l += __shfl_xor(l, 16); l += __shfl_xor(l, 32);
            LAS unsigned* mg = (LAS unsigned*)(lds + NAT_MRG + jq * 2560 + lane * 4);
            if (half == 1) {
                mg[0] = __float_as_uint(mx); mg[64] = __float_as_uint(l);
#pragma unroll
                for (int nt = 0; nt < 4; ++nt) { mg[64 * (2 + 2 * nt)] = cvt_pk_bf16(o[nt][0], o[nt][1]); mg[64 * (3 + 2 * nt)] = cvt_pk_bf16(o[nt][2], o[nt][3]); }
            }
            asm volatile("s_waitcnt lgkmcnt(0)" ::: "memory"); __builtin_amdgcn_s_barrier(); asm volatile("" ::: "memory");
            if (half == 0) {
                const float mx1 = __uint_as_float(mg[0]), l1 = __uint_as_float(mg[64]);
                const float M = fmaxf(mx, mx1), w0 = __builtin_amdgcn_exp2f(mx - M), w1 = __builtin_amdgcn_exp2f(mx1 - M);
                const float rl = 1.f / (l * w0 + l1 * w1), a0 = w0 * rl, a1 = w1 * rl;
                unsigned ow[8];
#pragma unroll
                for (int nt = 0; nt < 4; ++nt) {
                    const unsigned u0 = mg[64 * (2 + 2 * nt)], u1 = mg[64 * (3 + 2 * nt)];
                    ow[2 * nt] = cvt_pk_bf16(o[nt][0] * a0 + bf_lo(u0) * a1, o[nt][1] * a0 + bf_hi(u0) * a1);
                    ow[2 * nt + 1] = cvt_pk_bf16(o[nt][2] * a0 + bf_lo(u1) * a1, o[nt][3] * a0 + bf_hi(u1) * a1);
                }
                pw0 = (u32x4){ow[0], ow[1], ow[2], ow[3]}; pw1 = (u32x4){ow[4], ow[5], ow[6], ow[7]};
            }
            q0 = qn0; q1 = qn1; qrow += (size_t)64 * LDA_QK;
        }
        if (half == 0 && !dry) { bf16_t* op = qrow - (size_t)64 * LDA_QK + 16 * fq; *(u32x4*)op = pw0; *(u32x4*)(op + 8) = pw1; }
        asm volatile("s_waitcnt vmcnt(0) lgkmcnt(0)" ::: "memory"); __builtin_amdgcn_s_barrier(); asm volatile("" ::: "memory");
    }
#undef NAT_PIECE
}

__device__ __forceinline__ void phase_dilated(PP p, int chunk, int dry, unsigned char* lds_g) {
    LAS unsigned char* lds = (LAS unsigned char*)lds_g;
    const int tid = tid_(), wid = __builtin_amdgcn_readfirstlane(tid >> 6), lane = tid & 63, fr = lane & 15, fq = lane >> 4;
    bf16_t* QK3 = (bf16_t*)(p->ws + WS_R);
    const bf16_t* VT3 = (const bf16_t*)(p->ws + WS_R + R_VT);
    float* lse = (float*)(p->ws + WS_LSE);
    const int log2S = chunk == 0 ? 12 : 14;
    const int krt = 8 * (fr >> 2) + (fr & 3);
    const int NTASK = 3 * 16 * 128;
    const int G = (int)gridDim.x, b0 = bid_();
#define DIL_BLK(x_) (((((x_) & 7) << 4) | (((x_) >> 3) & 15)))
#define DIL_FILL(bt_, buf_) do { \
        const int g_ = (bt_) >> 11, rem_ = (bt_) & 2047, h_ = rem_ >> 7, blk_ = DIL_BLK(rem_); \
        const int L_ = 1 << (log2S - 2 * g_), p0b_ = blk_ * 128, u0b_ = p0b_ & (L_ - 1), lb_ = p0b_ - u0b_; \
        const bf16_t* Kg_ = QK3 + g_ * 2048 + 1024 + h_ * 64; \
        const bf16_t* VT_ = VT3 + (size_t)g_ * 1024 * LDB_VT + (size_t)(h_ * 64) * LDB_VT + lb_; \
        const int kb_ = u0b_ - 64 + 32 * wid; \
        LAS unsigned char* dst_ = lds + (buf_) * 65536 + wid * 4096; \
        _Pragma("unroll") for (int tt = 0; tt < 2; ++tt) { \
            int u_ = kb_ + krt + 4 * tt; u_ = u_ < 0 ? 0 : (u_ > L_ - 1 ? L_ - 1 : u_); \
            const bf16_t* kp_ = Kg_ + (size_t)(lb_ + u_) * LDB_QK + 8 * fq; \
            _Pragma("unroll") for (int kk = 0; kk < 2; ++kk) \
                __builtin_amdgcn_global_load_lds((const unsigned*)(kp_ + 32 * kk), (LAS unsigned*)(dst_ + tt * 2048 + kk * 1024), 16, 0, 0); } \
        int uv_ = kb_ + 8 * fq; uv_ = uv_ < 0 ? 0 : (uv_ > L_ - 8 ? L_ - 8 : uv_); \
        _Pragma("unroll") for (int nt = 0; nt < 4; ++nt) \
            __builtin_amdgcn_global_load_lds((const unsigned*)(VT_ + (size_t)(16 * (fr >> 2) + 4 * nt + (fr & 3)) * LDB_VT + uv_), (LAS unsigned*)(dst_ + 32768 + nt * 1024), 16, 0, 0); \
    } while (0)
    const int ddl = -64 - 16 * (wid & 1) + 8 * fq - fr;
    float mb[5][2][4];
#pragma unroll
    for (int ks = 0; ks < 5; ++ks)
#pragma unroll
        for (int tt = 0; tt < 2; ++tt)
#pragma unroll
            for (int e = 0; e < 4; ++e) { const int dd = ddl + 32 * ks + 4 * tt + e; mb[ks][tt][e] = (dd <= 64 && dd >= -64) ? 0.f : -1e30f; }
    if (b0 < NTASK) DIL_FILL(b0, 0);
    int it = 0;
#define DIL_QROW(bt_) (QK3 + ((bt_) >> 11) * 2048 + (((bt_) & 2047) >> 7) * 64 + (size_t)(DIL_BLK(bt_) * 128 + wid * 16 + fr) * LDB_QK)
    bf16x8 q0 = {0, 0, 0, 0, 0, 0, 0, 0}, q1 = q0;
    if (b0 < NTASK) { const bf16_t* qr = DIL_QROW(b0); q0 = *(const bf16x8*)(qr + 8 * fq); q1 = *(const bf16x8*)(qr + 8 * fq + 32); }
    u32x4 pw0 = {0u, 0u, 0u, 0u}, pw1 = pw0;
    for (int bt = b0; bt < NTASK; bt += G, ++it) {
        const int buf = it & 1;
        asm volatile("s_waitcnt vmcnt(0)" ::: "memory"); __builtin_amdgcn_s_barrier(); asm volatile("" ::: "memory");
        const int g = bt >> 11, rem = bt & 2047, h = rem >> 7, blk = DIL_BLK(rem);
        const int L = 1 << (log2S - 2 * g);
        const int p0 = blk * 128 + wid * 16;
        const int u0b = (blk * 128) & (L - 1);
        bf16x8 qn0 = q0, qn1 = q1;
        if (bt + G < NTASK) { const bf16_t* qr = DIL_QROW(bt + G); qn0 = *(const bf16x8*)(qr + 8 * fq); qn1 = *(const bf16x8*)(qr + 8 * fq + 32); }
        if (bt + G < NTASK) DIL_FILL(bt + G, buf ^ 1);
        if (it > 0 && !dry) { bf16_t* op = DIL_QROW(bt - G) + 16 * fq; *(u32x4*)op = pw0; *(u32x4*)(op + 8) = pw1; }
        const int ks0 = wid >> 1;
        const LAS unsigned char* fb = lds + buf * 65536 + ks0 * 4096 + lane * 16;
        const bool edge = (u0b < 64) || (u0b + 192 > L);
        f32x4 s[5][2];
        float mx = -1e30f;
#define DIL_LOADK(ks_, KF) do { _Pragma("unroll") for (int f = 0; f < 4; ++f) KF[f] = *(const LAS bf16x8*)(fb + (ks_) * 4096 + f * 1024); } while (0)
#define DIL_SCORE(ks_, KF) do { _Pragma("unroll") for (int tt = 0; tt < 2; ++tt) { \
            f32x4 a_ = {mb[ks_][tt][0], mb[ks_][tt][1], mb[ks_][tt][2], mb[ks_][tt][3]};     \
            a_ = __builtin_amdgcn_mfma_f32_16x16x32_bf16(KF[tt * 2], q0, a_, 0, 0, 0); \
            a_ = __builtin_amdgcn_mfma_f32_16x16x32_bf16(KF[tt * 2 + 1], q1, a_, 0, 0, 0); \
            _Pragma("unroll") for (int e = 0; e < 4; ++e) { \
                float v_ = a_[e]; \
                if (edge) { const int uk_ = u0b + 16 * wid + fr + ddl + (32 * (ks_) + 4 * tt + e); if (uk_ < 0 || uk_ >= L) v_ = -1e30f; } \
                s[ks_][tt][e] = v_; mx = fmaxf(mx, v_); } } } while (0)
        {
            bf16x8 kfA[4], kfB[4];
            DIL_LOADK(0, kfA);
            DIL_LOADK(1, kfB); __builtin_amdgcn_sched_barrier(0);
            DIL_SCORE(0, kfA); __builtin_amdgcn_sched_barrier(0);
            DIL_LOADK(2, kfA); __builtin_amdgcn_sched_barrier(0);
            DIL_SCORE(1, kfB); __builtin_amdgcn_sched_barrier(0);
            DIL_LOADK(3, kfB); __builtin_amdgcn_sched_barrier(0);
            DIL_SCORE(2, kfA); __builtin_amdgcn_sched_barrier(0);
            DIL_LOADK(4, kfA); __builtin_amdgcn_sched_barrier(0);
            DIL_SCORE(3, kfB); __builtin_amdgcn_sched_barrier(0);
            DIL_SCORE(4, kfA);
        }
#undef DIL_LOADK
#undef DIL_SCORE
        mx = fmaxf(mx, __shfl_xor(mx, 16)); mx = fmaxf(mx, __shfl_xor(mx, 32));
        float l = 0;
        f32x4 o[4];
#pragma unroll
        for (int nt = 0; nt < 4; ++nt) o[nt] = (f32x4){0.f, 0.f, 0.f, 0.f};
#define DIL_LOADV(ks_, VF) do { _Pragma("unroll") for (int f = 0; f < 4; ++f) VF[f] = *(const LAS bf16x8*)(fb + 32768 + (ks_) * 4096 + f * 1024); } while (0)
#define DIL_PV(ks_, VF) do { float pv_[8]; \
            _Pragma("unroll") for (int tt = 0; tt < 2; ++tt) _Pragma("unroll") for (int e = 0; e < 4; ++e) { const float pe_ = __builtin_amdgcn_exp2f(s[ks_][tt][e] - mx); pv_[4 * tt + e] = pe_; l += pe_; } \
            u32x4 w_; w_.x = cvt_pk_bf16(pv_[0], pv_[1]); w_.y = cvt_pk_bf16(pv_[2], pv_[3]); w_.z = cvt_pk_bf16(pv_[4], pv_[5]); w_.w = cvt_pk_bf16(pv_[6], pv_[7]); \
            const bf16x8 pa_ = *reinterpret_cast<bf16x8*>(&w_); \
            _Pragma("unroll") for (int nt = 0; nt < 4; ++nt) o[nt] = __builtin_amdgcn_mfma_f32_16x16x32_bf16(VF[nt], pa_, o[nt], 0, 0, 0); } while (0)
        {
            bf16x8 vfA[4], vfB[4];
            DIL_LOADV(0, vfA);
            DIL_LOADV(1, vfB); __builtin_amdgcn_sched_barrier(0);
            DIL_PV(0, vfA); __builtin_amdgcn_sched_barrier(0);
            DIL_LOADV(2, vfA); __builtin_amdgcn_sched_barrier(0);
            DIL_PV(1, vfB); __builtin_amdgcn_sched_barrier(0);
            DIL_LOADV(3, vfB); __builtin_amdgcn_sched_barrier(0);
            DIL_PV(2, vfA); __builtin_amdgcn_sched_barrier(0);
            DIL_LOADV(4, vfA); __builtin_amdgcn_sched_barrier(0);
            DIL_PV(3, vfB); __builtin_amdgcn_sched_barrier(0);
            DIL_PV(4, vfA);
        }
#undef DIL_LOADV
#undef DIL_PV
        l += __shfl_xor(l, 16); l += __shfl_xor(l, 32);
        const float rl = 1.f / l;
        if (fq == 0 && !dry) lse[((size_t)g * 16384 + p0 + fr) * 16 + h] = mx + __log2f(l);
        u32x4 w0, w1;
        w0.x = cvt_pk_bf16(o[0][0] * rl, o[0][1] * rl); w0.y = cvt_pk_bf16(o[0][2] * rl, o[0][3] * rl); w0.z = cvt_pk_bf16(o[1][0] * rl, o[1][1] * rl); w0.w = cvt_pk_bf16(o[1][2] * rl, o[1][3] * rl);
        w1.x = cvt_pk_bf16(o[2][0] * rl, o[2][1] * rl); w1.y = cvt_pk_bf16(o[2][2] * rl, o[2][3] * rl); w1.z = cvt_pk_bf16(o[3][0] * rl, o[3][1] * rl); w1.w = cvt_pk_bf16(o[3][2] * rl, o[3][3] * rl);
        pw0 = w0; pw1 = w1; q0 = qn0; q1 = qn1;
    }
    if (it > 0 && !dry) { bf16_t* op = DIL_QROW(b0 + (it - 1) * G) + 16 * fq; *(u32x4*)op = pw0; *(u32x4*)(op + 8) = pw1; }
#undef DIL_FILL
#undef DIL_QROW
#undef DIL_BLK
    asm volatile("s_waitcnt vmcnt(0)" ::: "memory"); __builtin_amdgcn_s_barrier();
}

__device__ __forceinline__ void phase_merge(PP p, int chunk) {
    const bf16_t* QK3 = (const bf16_t*)(p->ws + WS_R);
    const float* lse = (const float*)(p->ws + WS_LSE);
    bf16_t* Om = (bf16_t*)(p->ws + WS_H) + (size_t)chunk * 16384 * DM;
    const int log2S = chunk == 0 ? 12 : 14; const int Smask = (1 << log2S) - 1;
    for (int it = bid_() * NTHREADS + tid_(); it < 16384 * 64; it += gridDim.x * NTHREADS) {
        const int n = it >> 6, hq = it & 63, h = hq >> 2;
        const int sb = n >> log2S, t = n & Smask;
        int pg[3]; float ls[3];
#pragma unroll
        for (int g = 0; g < 3; ++g) {
            const int ld = 2 * g;
            pg[g] = (sb << log2S) + ((t & ((1 << ld) - 1)) << (log2S - ld)) + (t >> ld);
            ls[g] = lse[((size_t)g * 16384 + pg[g]) * 16 + h];
        }
        const float mx = fmaxf(ls[0], fmaxf(ls[1], ls[2]));
        float w[3]; w[0] = __builtin_amdgcn_exp2f(ls[0] - mx); w[1] = __builtin_amdgcn_exp2f(ls[1] - mx); w[2] = __builtin_amdgcn_exp2f(ls[2] - mx);
        const float inv = 1.f / (w[0] + w[1] + w[2]);
        float acc[16];
#pragma unroll
        for (int e = 0; e < 16; ++e) acc[e] = 0.f;
#pragma unroll
        for (int g = 0; g < 3; ++g) {
            const bf16_t* op = QK3 + (size_t)pg[g] * LDB_QK + g * 2048 + hq * 16;
            const u32x4 a = *(const u32x4*)op, b = *(const u32x4*)(op + 8);
            const float wg = w[g] * inv;
            acc[0] += wg * bf_lo(a.x); acc[1] += wg * bf_hi(a.x); acc[2] += wg * bf_lo(a.y); acc[3] += wg * bf_hi(a.y);
            acc[4] += wg * bf_lo(a.z); acc[5] += wg * bf_hi(a.z); acc[6] += wg * bf_lo(a.w); acc[7] += wg * bf_hi(a.w);
            acc[8] += wg * bf_lo(b.x); acc[9] += wg * bf_hi(b.x); acc[10] += wg * bf_lo(b.y); acc[11] += wg * bf_hi(b.y);
            acc[12] += wg * bf_lo(b.z); acc[13] += wg * bf_hi(b.z); acc[14] += wg * bf_lo(b.w); acc[15] += wg * bf_hi(b.w);
        }
        u32x4 o0, o1;
        o0.x = cvt_pk_bf16(acc[0], acc[1]); o0.y = cvt_pk_bf16(acc[2], acc[3]); o0.z = cvt_pk_bf16(acc[4], acc[5]); o0.w = cvt_pk_bf16(acc[6], acc[7]);
        o1.x = cvt_pk_bf16(acc[8], acc[9]); o1.y = cvt_pk_bf16(acc[10], acc[11]); o1.z = cvt_pk_bf16(acc[12], acc[13]); o1.w = cvt_pk_bf16(acc[14], acc[15]);
        bf16_t* dst = Om + (size_t)n * DM + hq * 16;
        *(u32x4*)dst = o0; *(u32x4*)(dst + 8) = o1;
    }
}

struct QknTok { u32x4 ua0, ub0, ua1, ub1; f32x4 cs[4]; };
__device__ __forceinline__ void qkn_load(bf16_t* QKV, const float* rope, int m, int hs, int half, int c, QknTok& q) {
    const int t = m < TP ? (m & 4095) : ((m - TP) & 16383);
    const int pos = half ? (t & 63) : (t >> 6);
    const float* tp = rope + ((size_t)pos * 32 + 8 * c) * 2;
#pragma unroll
    for (int e = 0; e < 4; ++e) q.cs[e] = *(const f32x4*)(tp + 4 * e);
    const bf16_t* xp = QKV + (size_t)m * 1536 + hs * 128 + half * 64 + 8 * c;
    q.ua0 = *(const u32x4*)xp; q.ub0 = *(const u32x4*)(xp + 32);
    q.ua1 = q.ua0; q.ub1 = q.ub0;
    if (hs < 2) { q.ua1 = *(const u32x4*)(xp + 1024); q.ub1 = *(const u32x4*)(xp + 1024 + 32); }
}
__device__ __forceinline__ void qkn_one(bf16_t* xp, const u32x4 ua, const u32x4 ub, const f32x4 (&cs)[4], const f32x4 (&g)[4]) {
    float a[8], b[8];
    a[0] = bf_lo(ua.x); a[1] = bf_hi(ua.x); a[2] = bf_lo(ua.y); a[3] = bf_hi(ua.y); a[4] = bf_lo(ua.z); a[5] = bf_hi(ua.z); a[6] = bf_lo(ua.w); a[7] = bf_hi(ua.w);
    b[0] = bf_lo(ub.x); b[1] = bf_hi(ub.x); b[2] = bf_lo(ub.y); b[3] = bf_hi(ub.y); b[4] = bf_lo(ub.z); b[5] = bf_hi(ub.z); b[6] = bf_lo(ub.w); b[7] = bf_hi(ub.w);
    float ss = 0;
#pragma unroll
    for (int e = 0; e < 8; ++e) ss += a[e] * a[e] + b[e] * b[e];
    ss += __shfl_xor(ss, 1); ss += __shfl_xor(ss, 2); ss += __shfl_xor(ss, 4);
    const float rstd = rsqrtf(ss * (1.f / 128.f) + EPS);
    float ra[8], rb[8];
#pragma unroll
    for (int e = 0; e < 8; ++e) {
        const float xa = a[e] * rstd * g[e >> 2][e & 3], xb = b[e] * rstd * g[2 + (e >> 2)][e & 3];
        const float co = cs[e >> 1][(e & 1) * 2], si = cs[e >> 1][(e & 1) * 2 + 1];
        ra[e] = xa * co - xb * si; rb[e] = xa * si + xb * co;
    }
    u32x4 wa, wb;
    wa.x = cvt_pk_bf16(ra[0], ra[1]); wa.y = cvt_pk_bf16(ra[2], ra[3]); wa.z = cvt_pk_bf16(ra[4], ra[5]); wa.w = cvt_pk_bf16(ra[6], ra[7]);
    wb.x = cvt_pk_bf16(rb[0], rb[1]); wb.y = cvt_pk_bf16(rb[2], rb[3]); wb.z = cvt_pk_bf16(rb[4], rb[5]); wb.w = cvt_pk_bf16(rb[6], rb[7]);
    *(u32x4*)xp = wa; *(u32x4*)(xp + 32) = wb;
}
__device__ __forceinline__ void qkn_finish(bf16_t* QKV, int m, int hs, int half, int c, const QknTok& q, const f32x4 (&gq)[4], const f32x4 (&gk)[4]) {
    bf16_t* xp = QKV + (size_t)m * 1536 + hs * 128 + half * 64 + 8 * c;
    qkn_one(xp, q.ua0, q.ub0, q.cs, gq);
    if (hs < 2) qkn_one(xp + 1024, q.ua1, q.ub1, q.cs, gk);
}
__device__ __forceinline__ void phase_qknorm(PP p) {
    const int tid = tid_(), wid = tid >> 6, lane = tid & 63;
    const int nw = gridDim.x * 8, wg = bid_() * 8 + wid;
    bf16_t* QKV = (bf16_t*)(p->ws + WS_R);
    const float* rope = (const float*)(p->ws + WS_ROPE);
    const int hs = lane >> 3, half = (lane >> 2) & 1, c = lane & 3;
    f32x4 gq[4], gk[4];
    { const float* gv = p->c_q_g + half * 64 + 8 * c; gq[0] = *(const f32x4*)gv; gq[1] = *(const f32x4*)(gv + 4); gq[2] = *(const f32x4*)(gv + 32); gq[3] = *(const f32x4*)(gv + 36); }
    { const float* gv = p->c_k_g + half * 64 + 8 * c; gk[0] = *(const f32x4*)gv; gk[1] = *(const f32x4*)(gv + 4); gk[2] = *(const f32x4*)(gv + 32); gk[3] = *(const f32x4*)(gv + 36); }
    for (int m = wg; m < T; m += 2 * nw) {
        QknTok A, B;
        const bool hb = m + nw < T;
        qkn_load(QKV, rope, m, hs, half, c, A);
        qkn_load(QKV, rope, hb ? m + nw : m, hs, half, c, B);
        __builtin_amdgcn_sched_barrier(0);
        qkn_finish(QKV, m, hs, half, c, A, gq, gk);
        if (hb) qkn_finish(QKV, m + nw, hs, half, c, B, gq, gk);
    }
}

__device__ __forceinline__ void phase_attn_c(PP p, unsigned char* lds, int dry) {
    const bf16_t* QKV = (const bf16_t*)(p->ws + WS_R);
    bf16_t* O = (bf16_t*)(p->ws + WS_R + 144 * MiB);
    for (int u = bid_(); u < 1536; u += gridDim.x) {
        int start, len, h, qb;
        if (u < 1024) { const int sb = u >> 9; h = (u >> 6) & 7; qb = u & 63; start = TP + sb * 16384; len = 16384; }
        else { const int v = u - 1024; const int sb = v >> 7; h = (v >> 4) & 7; qb = v & 15; start = sb * 4096; len = 4096; }
        const size_t q0 = (size_t)(start + qb * 256);
        att::attn_dense_body(QKV + q0 * 1536 + h * 128, QKV + (size_t)start * 1536 + 1024 + (h >> 2) * 128, QKV + (size_t)start * 1536 + 1280 + (h >> 2) * 128,
                             O + q0 * 1024 + h * 128, len, (char*)lds, dry);
        __syncthreads();
    }
}

__device__ __forceinline__ bool gemm_job(PP p, const Ph ph, int jn, pg8::Gemm& g, pg8::Epi& e) {
    const bf16_t* W = (const bf16_t*)(p->ws + WS_W);
    const bf16_t* H = (const bf16_t*)(p->ws + WS_H);
    bf16_t* Rb = (bf16_t*)(p->ws + WS_R);
    e.mode = 0; e.O = nullptr; e.ldc = 0; e.log2L = 0; e.log2d = 0; e.rope = (const float*)(p->ws + WS_ROPE); e.base_p = nullptr; e.base_s = nullptr; e.baseb = (const bf16_t*)p->out; e.outb = (bf16_t*)p->out; e.gate = nullptr; e.row_off = 0;
    g.lda = 1024; g.ldb = 1024; g.K = 1024; g.pA_L = -1; g.pA_d = 0; g.pA_S = 0; g.pB_L = -1; g.pB_d = 0; g.pB_S = 0;
    const int type = ph.type & 0xff;
    if (type == PH_QKV_A) {
        const bf16_t* Wq = W + W_AQKV + (size_t)ph.a * 3072 * 1024;
        if (jn == 0) { g.A = H; g.Bt = Wq; g.M = T; g.N = 2048; e.O = Rb; e.ldc = LDA_QK; return true; }
        if (jn == 1) { g.A = Wq + (size_t)2048 * 1024; g.Bt = H; g.M = 1024; g.N = T; e.O = Rb + R_VT / 2; e.ldc = LDA_VT; return true; }
        return false;
    }
    if (type == PH_WO) {
        if (jn != 0) return false;
        e.mode = 3; e.gate = (const float*)(p->ws + WS_MOD) + ((size_t)ph.a * 6 + 2) * DM;
        if (ph.a == 0) { e.base_p = p->x_prompt; e.base_s = p->x_sample; }
        g.N = 1024;
        if (ph.b == 0) { g.A = Rb; g.lda = LDA_QK; g.Bt = W + W_AO + (size_t)ph.c * 1024 * 1024; g.M = T; }
        else if (ph.b == 1) { g.A = H; g.Bt = W + W_BO; g.M = T; }
        else { g.A = Rb + (size_t)72 * MiB; g.Bt = W + W_CO; g.M = T; }
        return true;
    }
    if (type == PH_MLP) {
        const int step = ph.b;
        const bool has_down = step >= 1, has_up = step <= 2;
        const int which = (jn == 0) ? (has_down ? 0 : 1) : ((jn == 1 && has_down && has_up) ? 1 : 2);
        if (which == 0) {
            const int c = step - 1;
            e.mode = 3; e.gate = (const float*)(p->ws + WS_MOD) + ((size_t)ph.a * 6 + 5) * DM; e.row_off = c * 16384;
            if (ph.a == 3) e.outb = (bf16_t*)(p->ws + WS_H);
            g.A = Rb + (size_t)(c & 1) * 70 * MiB; g.lda = LDU; g.Bt = W + W_2 + (size_t)ph.a * 1024 * 4096; g.ldb = 4096; g.M = 16384; g.N = 1024; g.K = 4096;
            return true;
        }
        if (which == 1) {
            const int c = step;
            e.mode = 2; e.O = Rb + (size_t)(c & 1) * 70 * MiB; e.ldc = LDU;
            g.A = H + (size_t)c * 16384 * 1024; g.Bt = W + W_1 + (size_t)ph.a * 4096 * 1024; g.M = 16384; g.N = 4096;
            return true;
        }
        return false;
    }
    if (type == PH_QKV_B) {
        if (jn >= 6) return false;
        const int gi = jn >> 1;
        const int log2S = ph.c == 0 ? 12 : 14, log2d = 2 * gi, log2L = log2S - log2d;
        const bf16_t* Hc = H + (size_t)ph.c * 16384 * 1024;
        const bf16_t* Wg = W + W_BQKV + (size_t)gi * 3072 * 1024;
        if ((jn & 1) == 0) { e.mode = 1; e.O = Rb + gi * 2048; e.ldc = LDB_QK; e.log2d = log2d; e.log2L = log2L;
            g.A = Hc; g.lda = 1024 << log2d; g.pA_L = log2L; g.pA_d = log2d; g.pA_S = log2S; g.Bt = Wg; g.M = 16384; g.N = 2048; }
        else { e.O = Rb + R_VT / 2 + (size_t)gi * 1024 * LDB_VT; e.ldc = LDB_VT; g.A = Wg + (size_t)2048 * 1024;
            g.Bt = Hc; g.ldb = 1024 << log2d; g.pB_L = log2L; g.pB_d = log2d; g.pB_S = log2S; g.M = 1024; g.N = 16384; }
        return true;
    }
    if (type == PH_QKV_C) {
        if (jn != 0) return false;
        g.A = H; g.Bt = W + W_CQKV; g.M = T; g.N = 1536; e.O = Rb; e.ldc = 1536; return true;
    }
    return false;
}

__device__ __forceinline__ void run_phase(PP p, const Ph ph, unsigned char* lds) {
    const int type = ph.type & 0xff; const int dry = ph.type >> 8;
    if (type == PH_QKV_A || type == PH_WO || type == PH_MLP || type == PH_QKV_B || type == PH_QKV_C) {
#pragma unroll 1
        for (int jn = 0; jn < 6; ++jn) {
            pg8::Gemm g; pg8::Epi e;
            if (!gemm_job(p, ph, jn, g, e)) break;
            e.dry = dry;
            pg8::StaticOrder S; S.init(g.M, g.N, (int)gridDim.x, bid_());
            pg8::gemm_phase((LAS unsigned char*)lds, g, S, e);
        }
        return;
    }
    switch (type) {
    case PH_INIT: phase_init(p, lds); break;
    case PH_MOD:
        if (ph.c < 0) phase_modulate(p, ph.a, ph.b, 0, T, 0); else phase_modulate(p, ph.a, ph.b, ph.c * 16384, 16384, 1);
        break;
    case PH_NATTEN: phase_natten(p, ph.a, dry, lds); break;
    case PH_DIL: phase_dilated(p, ph.c, dry, lds); break;
    case PH_MERGE: phase_merge(p, ph.c); break;
    case PH_QKNORM: phase_qknorm(p); break;
    case PH_ATTN_C: phase_attn_c(p, lds, dry); break;
    case PH_FINAL: phase_final(p); break;
    default: break;
    }
}


#define XB_TMO      128
#define XB_XCNT(j)  (256  + 64 * (j))
#define XB_XSUB(j)  (1280 + 64 * (j))
#define XB_XGEN(j)  (2304 + 64 * (j))
#define XB_TOP      3328
#define XB_TOPGEN   3392
#define XCD_BAR_WORDS 3456
#define XB_SPIN_CAP (1u << 22)
__device__ __forceinline__ unsigned xb_ld(unsigned* p)              { return __hip_atomic_load(p, __ATOMIC_RELAXED, __HIP_MEMORY_SCOPE_AGENT); }
__device__ __forceinline__ unsigned xb_add(unsigned* p, unsigned v) { return __hip_atomic_fetch_add(p, v, __ATOMIC_RELAXED, __HIP_MEMORY_SCOPE_AGENT); }
__device__ __forceinline__ unsigned xb_xcc_id() { return (unsigned)__builtin_amdgcn_s_getreg((3 << 11) | 20) & 0xFu; }
#define XB_SPIN(cond, bar) do { unsigned _sp = 0; while (cond) { __builtin_amdgcn_s_sleep(1); \
    if ((++_sp & 255u) == 0u) { if (xb_ld(&(bar)[XB_TMO])) break; if (_sp > XB_SPIN_CAP) { atomicAdd(&(bar)[XB_TMO], 1u); break; } } } } while (0)
__device__ __forceinline__ void xcd_barrier_complete(unsigned* bar, unsigned x, unsigned& nloc, unsigned& nx) {
    const unsigned G = gridDim.x;
    unsigned sum, cnt, mine, sp = 0u;
    for (;;) {
        sum = 0u; cnt = 0u; mine = 0u;
#pragma unroll
        for (unsigned j = 0; j < 16; ++j) { const unsigned c = xb_ld(&bar[XB_XCNT(j)]); sum += c; cnt += (c > 0u) ? 1u : 0u; mine = (j == x) ? c : mine; }
        if (sum == G) break;
        __builtin_amdgcn_s_sleep(1);
        if ((++sp & 255u) == 0u) { if (xb_ld(&bar[XB_TMO])) break; if (sp > XB_SPIN_CAP) { atomicAdd(&bar[XB_TMO], 1u); break; } }
    }
    nloc = mine > 0u ? mine : 1u; nx = cnt > 0u ? cnt : 1u;
}
__device__ __forceinline__ void xcd_barrier(unsigned* bar, volatile LAS unsigned* st) {
    asm volatile("s_waitcnt vmcnt(0)" ::: "memory");
    __syncthreads();
    if (threadIdx.x == 0) {
        const unsigned x = xb_xcc_id();
        __builtin_amdgcn_s_waitcnt(0);
        unsigned nloc = st[0], nx = st[1];
        if (nloc == 0u) { xcd_barrier_complete(bar, x, nloc, nx); st[0] = nloc; st[1] = nx; }
        const unsigned old = xb_add(&bar[XB_XSUB(x)], 1u);
        const unsigned gen = old / nloc;
        if (old + 1u == (gen + 1u) * nloc) {
            __builtin_amdgcn_fence(__ATOMIC_RELEASE, "agent");
            asm volatile("s_waitcnt vmcnt(0)" ::: "memory");
            const unsigned og = xb_add(&bar[XB_TOP], 1u);
            const unsigned tg = og / nx;
            if (og + 1u == (tg + 1u) * nx) xb_add(&bar[XB_TOPGEN], 1u);
            else XB_SPIN(xb_ld(&bar[XB_TOPGEN]) == tg, bar);
            __builtin_amdgcn_fence(__ATOMIC_ACQUIRE, "agent");
            xb_add(&bar[XB_XGEN(x)], 1u);
            asm volatile("s_waitcnt vmcnt(0)" ::: "memory");
        } else {
            XB_SPIN(xb_ld(&bar[XB_XGEN(x)]) == gen, bar);
            __builtin_amdgcn_fence(__ATOMIC_ACQUIRE, "agent");
            asm volatile("s_waitcnt vmcnt(0)" ::: "memory");
        }
    }
    __syncthreads();
}

__global__ void __launch_bounds__(NTHREADS, 2) mk_fwd(Params p, int ph0, int ph1) {
    extern __shared__ __attribute__((aligned(16))) unsigned char lds[];
    cg::grid_group grid = cg::this_grid();
    volatile LAS unsigned* st = (volatile LAS unsigned*)((LAS unsigned char*)lds + (LDS_BYTES - 16));
    if (threadIdx.x == 0) { st[0] = 0u; st[1] = 0u; }
    __syncthreads();
    if (ph1 - ph0 > 1 && threadIdx.x == 0) (void)xb_add((unsigned*)(p.ws + WS_BAR) + XB_XCNT(xb_xcc_id()), 1u);
    for (int i = ph0; i < ph1; ++i) {
        run_phase(params_(), g_tab.v[i], lds);
        if (i + 1 < ph1) {
            if (p.nph < 0) { __syncthreads(); grid.sync(); }
            xcd_barrier((unsigned*)(params_()->ws + WS_BAR), st);
        }
    }
}


extern "C" void kernel_launch(void* const* d_in, const int* in_sizes, int n_in, void* d_out, int out_size, void* d_ws, size_t ws_size, hipStream_t stream) {
    static int grid = 0;
    if (grid == 0) {
        if (n_in != 19 || out_size != T * DM || ws_size < WS_END) { fprintf(stderr, "kernel_launch: unexpected shapes: n_in %d out %d ws %zu\n", n_in, out_size, ws_size); grid = -1; return; }
        int dev = 0, cus = 0, per_cu = 0;
        hipGetDevice(&dev); hipDeviceGetAttribute(&cus, hipDeviceAttributeMultiprocessorCount, dev);
        if (hipFuncSetAttribute((const void*)mk_fwd, hipFuncAttributeMaxDynamicSharedMemorySize, LDS_BYTES) != hipSuccess) { fprintf(stderr, "kernel_launch: hipFuncSetAttribute failed\n"); grid = -1; return; }
        if (hipOccupancyMaxActiveBlocksPerMultiprocessor(&per_cu, (const void*)mk_fwd, NTHREADS, LDS_BYTES) != hipSuccess || per_cu < 1) { fprintf(stderr, "kernel_launch: occupancy query says %d\n", per_cu); per_cu = 1; }
        (void)hipGetLastError();
        grid = cus * per_cu;
    }
    if (grid < 0) return;
    Params p{};
    p.x_prompt = (const float*)d_in[0]; p.x_sample = (const float*)d_in[1]; p.c_prompt = (const float*)d_in[2]; p.c_sample = (const float*)d_in[3];
    p.w_mod = (const float*)d_in[4]; p.b_mod = (const float*)d_in[5]; p.norm_g = (const float*)d_in[6]; p.final_g = (const float*)d_in[7];
    p.a_w_qkv = (const float*)d_in[8]; p.a_rpb = (const float*)d_in[9]; p.a_w_o = (const float*)d_in[10]; p.b_w_qkv = (const float*)d_in[11]; p.b_w_o = (const float*)d_in[12];
    p.c_w_qkv = (const float*)d_in[13]; p.c_q_g = (const float*)d_in[14]; p.c_k_g = (const float*)d_in[15]; p.c_w_o = (const float*)d_in[16]; p.mlp_w1 = (const float*)d_in[17]; p.mlp_w2 = (const float*)d_in[18];
    p.out = (float*)d_out; p.ws = (unsigned char*)d_ws; p.nph = 0; p.pad = 0;
    if (hipMemsetAsync((char*)d_ws + WS_BAR, 0, XCD_BAR_WORDS * 4, stream) != hipSuccess) { fprintf(stderr, "kernel_launch: memset of barrier words failed\n"); return; }
    p.nph = H_TAB.n;
#if MK_MULTI
    for (int i = 0; i < p.nph; ++i) hipLaunchKernelGGL(mk_fwd, dim3(grid), dim3(NTHREADS), LDS_BYTES, stream, p, i, i + 1);
#else
    int ph0 = 0, ph1 = p.nph;
    void* args[] = {&p, &ph0, &ph1};
    hipError_t e = hipLaunchCooperativeKernel((const void*)mk_fwd, dim3(grid), dim3(NTHREADS), args, LDS_BYTES, stream);
    if (e != hipSuccess) fprintf(stderr, "kernel_launch: cooperative launch failed: %s (grid %d)\n", hipGetErrorString(e), grid);
#endif
}
```
